# Optimizing an MI355X kernel written in HIP

```python
import math
import jax, jax.numpy as jnp
from jax import lax
import numpy as np

D_MODEL = 2048
BATCH = 4
SEQ = 4096
DEPTH = 2

GRID_W = 64
CTX_LEN = 256
EPS = 1e-6
ROPE_BASE = 10000.0
Q_BLOCK = 128
DIFF_DH = 64
DIFF_HEADS = (D_MODEL // 2) // (2 * DIFF_DH)
DIFF_DV = 2 * DIFF_DH
DIFF_QK_W = DIFF_HEADS * 2 * DIFF_DH
DIFF_V_W = DIFF_HEADS * DIFF_DV
CONV_CH = D_MODEL // 2
CONV_W = 31
HY_IN = 2 * DIFF_QK_W + DIFF_V_W + 2 * CONV_CH
HY_OUT = DIFF_V_W + CONV_CH
ML_HEADS = 8
ML_DV = D_MODEL // ML_HEADS
ML_DK = ML_DV // 2
ML_QK_W = ML_HEADS * ML_DK
ML_V_W = ML_HEADS * ML_DV
ML_GATES = 4 * ML_HEADS
ML_IN = 2 * ML_QK_W + ML_V_W + ML_GATES + ML_V_W
ML_CONV_W = 3
ML_CHUNK = 64
D_FF = 4 * D_MODEL

kernel_name = "hybrid_diffattn_conformer_mlstm_dit"

F32 = jnp.float32


def rms_norm(x, g):
    xf = x.astype(F32)
    y = xf * lax.rsqrt(jnp.mean(jnp.square(xf), axis=-1, keepdims=True) + EPS)
    return (y * g.astype(F32)).astype(x.dtype)


def layer_norm(x, g, b):
    xf = x.astype(F32)
    mu = jnp.mean(xf, axis=-1, keepdims=True)
    var = jnp.mean(jnp.square(xf - mu), axis=-1, keepdims=True)
    return ((xf - mu) * lax.rsqrt(var + EPS) * g.astype(F32) + b.astype(F32)).astype(x.dtype)


def modulate(h, shift, scale):
    return h * (1.0 + scale) + shift


def dwconv(x, w, b):
    width = w.shape[0]
    pad = width // 2
    y = lax.conv_general_dilated(x, w[:, None, :], window_strides=(1,), padding=[(pad, width - 1 - pad)],
                                 dimension_numbers=("NWC", "WIO", "NWC"), feature_group_count=x.shape[-1])
    return y + b


def axial_rope_tables(T):
    rows = T // GRID_W
    r = jnp.broadcast_to(jnp.arange(rows)[:, None], (rows, GRID_W)).reshape(T).astype(F32)
    col = jnp.broadcast_to(jnp.arange(GRID_W)[None, :], (rows, GRID_W)).reshape(T).astype(F32)
    n_freq = DIFF_DH // 4
    inv = ROPE_BASE ** (-jnp.arange(n_freq, dtype=F32) / n_freq)
    ar = r[:, None] * inv
    ac = col[:, None] * inv
    ang = jnp.concatenate([ar, ar, ac, ac], axis=-1)
    return jnp.cos(ang), jnp.sin(ang)


def apply_axial_rope(x, cos, sin):
    q = DIFF_DH // 4
    x1, x2, x3, x4 = x[..., :q], x[..., q:2 * q], x[..., 2 * q:3 * q], x[..., 3 * q:]
    rot = jnp.concatenate([-x2, x1, -x4, x3], axis=-1)
    T = x.shape[1]
    c = cos.reshape(T, 1, 1, DIFF_DH).astype(x.dtype)
    s = sin.reshape(T, 1, 1, DIFF_DH).astype(x.dtype)
    return x * c + rot * s


def diff_attn_block(q, k, v, lam):
    s = jnp.einsum("bqhcd,bkhcd->bhcqk", q, k, preferred_element_type=F32) * (DIFF_DH ** -0.5)
    p = jax.nn.softmax(s, axis=-1)
    a = p[:, :, 0] - lam * p[:, :, 1]
    return jnp.einsum("bhqk,bkhe->bqhe", a.astype(v.dtype), v)


def conformer_conv(u, conv_w, conv_b, ln_g, ln_b):
    a, g = jnp.split(u, 2, axis=-1)
    y = dwconv(a * jax.nn.sigmoid(g), conv_w, conv_b)
    return jax.nn.silu(layer_norm(y, ln_g, ln_b))


def hybrid_mixer(hl, hc, w_in, w_out, lq1, lk1, lq2, lk2, subln_g, conv_w, conv_b, ln_g, ln_b, lam_init, need_ctx):
    Bsz, T, _ = hl.shape
    Cn = hc.shape[1]
    lam = (jnp.exp(jnp.sum(lq1.astype(F32) * lk1.astype(F32)))
           - jnp.exp(jnp.sum(lq2.astype(F32) * lk2.astype(F32))) + lam_init)

    def split_qkvu(z, n):
        q = z[..., :DIFF_QK_W].reshape(Bsz, n, DIFF_HEADS, 2, DIFF_DH)
        k = z[..., DIFF_QK_W:2 * DIFF_QK_W].reshape(Bsz, n, DIFF_HEADS, 2, DIFF_DH)
        v = z[..., 2 * DIFF_QK_W:2 * DIFF_QK_W + DIFF_V_W].reshape(Bsz, n, DIFF_HEADS, DIFF_DV)
        u = z[..., 2 * DIFF_QK_W + DIFF_V_W:]
        return q, k, v, u

    def finish(attn, u):
        n = attn.shape[1]
        attn = (rms_norm(attn, subln_g) * (1.0 - lam_init)).reshape(Bsz, n, DIFF_V_W)
        conv = conformer_conv(u, conv_w, conv_b, ln_g, ln_b)
        return jnp.concatenate([attn, conv], axis=-1) @ w_out

    ql, kl, vl, ul = split_qkvu(hl @ w_in, T)
    cos, sin = axial_rope_tables(T)
    ql = apply_axial_rope(ql, cos, sin)
    kl = apply_axial_rope(kl, cos, sin)

    if need_ctx:
        qc, kc, vc, uc = split_qkvu(hc @ w_in, Cn)
    else:
        zkv = hc @ w_in[:, DIFF_QK_W:2 * DIFF_QK_W + DIFF_V_W]
        kc = zkv[..., :DIFF_QK_W].reshape(Bsz, Cn, DIFF_HEADS, 2, DIFF_DH)
        vc = zkv[..., DIFF_QK_W:].reshape(Bsz, Cn, DIFF_HEADS, DIFF_DV)

    k_all = jnp.concatenate([kc, kl], axis=1)
    v_all = jnp.concatenate([vc, vl], axis=1)
    nb = T // Q_BLOCK
    qb = jnp.moveaxis(ql.reshape(Bsz, nb, Q_BLOCK, DIFF_HEADS, 2, DIFF_DH), 1, 0)
    ob = lax.map(lambda q: diff_attn_block(q, k_all, v_all, lam), qb)
    attn_l = jnp.moveaxis(ob, 0, 1).reshape(Bsz, T, DIFF_HEADS, DIFF_DV)
    y_lat = finish(attn_l, ul)

    y_ctx = None
    if need_ctx:
        attn_c = diff_attn_block(qc, kc, vc, lam)
        y_ctx = finish(attn_c, uc)
    return y_lat, y_ctx


def _to_chunks(a):
    Bsz, T, H = a.shape[:3]
    a = a.reshape(Bsz, T // ML_CHUNK, ML_CHUNK, H, *a.shape[3:])
    return jnp.moveaxis(a, (1, 3), (0, 2))


def mlstm_scan(q, k, v, ig, lf, state0):
    Bsz, T, H, _ = q.shape
    dv = v.shape[-1]
    tril = jnp.tril(jnp.ones((ML_CHUNK, ML_CHUNK), dtype=bool))
    xs = tuple(_to_chunks(a.astype(F32)) for a in (q, k, v, ig, lf))

    def step(carry, inp):
        C, n, m = carry
        qc, kc, vc, ic, fc = inp
        b = jnp.cumsum(fc, axis=-1)
        g = b + m[..., None]
        dlog = b[..., :, None] - b[..., None, :] + ic[..., None, :]
        dlog = jnp.where(tril, dlog, -jnp.inf)
        m_row = jnp.maximum(g, jnp.max(dlog, axis=-1))
        inter = jnp.exp(g - m_row)
        s = jnp.einsum("bhid,bhjd->bhij", qc, kc) * jnp.exp(dlog - m_row[..., None])
        num = inter[..., None] * jnp.einsum("bhid,bhde->bhie", qc, C) + jnp.einsum("bhij,bhje->bhie", s, vc)
        den = inter * jnp.einsum("bhid,bhd->bhi", qc, n) + jnp.sum(s, axis=-1)
        h = num / jnp.maximum(jnp.abs(den), jnp.exp(-m_row))[..., None]
        b_last = b[..., -1]
        wlog = b_last[..., None] - b + ic
        m_new = jnp.maximum(b_last + m, jnp.max(wlog, axis=-1))
        decay = jnp.exp(b_last + m - m_new)
        w = jnp.exp(wlog - m_new[..., None])
        C_new = decay[..., None, None] * C + jnp.einsum("bhjd,bhje->bhde", kc * w[..., None], vc)
        n_new = decay[..., None] * n + jnp.einsum("bhj,bhjd->bhd", w, kc)
        return (C_new, n_new, m_new), h

    state, hs = lax.scan(step, state0, xs)
    h = jnp.moveaxis(hs, (0, 2), (1, 3)).reshape(Bsz, T, H, dv)
    return h, state


def mlstm_mixer(hl, hc, w_in, conv_w, conv_b, gate_b, norm_g, w_out, need_ctx):
    Bsz = hl.shape[0]

    def project(h, with_o):
        n = h.shape[1]
        z = h @ (w_in if with_o else w_in[:, :ML_IN - ML_V_W])
        qk = jax.nn.silu(dwconv(z[..., :2 * ML_QK_W], conv_w, conv_b))
        q = qk[..., :ML_QK_W].reshape(Bsz, n, ML_HEADS, ML_DK)
        k = qk[..., ML_QK_W:].reshape(Bsz, n, ML_HEADS, ML_DK) * (ML_DK ** -0.5)
        v = z[..., 2 * ML_QK_W:2 * ML_QK_W + ML_V_W].reshape(Bsz, n, ML_HEADS, ML_DV)
        gates = (z[..., 2 * ML_QK_W + ML_V_W:2 * ML_QK_W + ML_V_W + ML_GATES] + gate_b).astype(F32)
        i_f, f_f, i_b, f_b = jnp.split(gates, 4, axis=-1)
        o = z[..., ML_IN - ML_V_W:] if with_o else None
        return q, k, v, (i_f, jax.nn.log_sigmoid(f_f)), (i_b, jax.nn.log_sigmoid(f_b)), o

    def flip(a):
        return jnp.flip(a, axis=1)

    zero = (jnp.zeros((Bsz, ML_HEADS, ML_DK, ML_DV), F32), jnp.zeros((Bsz, ML_HEADS, ML_DK), F32),
            jnp.zeros((Bsz, ML_HEADS), F32))

    qc, kc, vc, gfc, gbc, oc = project(hc, need_ctx)
    hc_f, st_f = mlstm_scan(qc, kc, vc, gfc[0], gfc[1], zero)
    hc_b, st_b = mlstm_scan(flip(qc), flip(kc), flip(vc), flip(gbc[0]), flip(gbc[1]), zero)

    ql, kl, vl, gfl, gbl, ol = project(hl, True)
    hl_f, _ = mlstm_scan(ql, kl, vl, gfl[0], gfl[1], st_f)
    hl_b, _ = mlstm_scan(flip(ql), flip(kl), flip(vl), flip(gbl[0]), flip(gbl[1]), st_b)

    def finish(h, o):
        n = h.shape[1]
        h = rms_norm(h.astype(o.dtype), norm_g).reshape(Bsz, n, ML_V_W)
        return (h * jax.nn.sigmoid(o)) @ w_out

    y_lat = finish(hl_f + flip(hl_b), ol)
    y_ctx = finish(hc_f + flip(hc_b), oc) if need_ctx else None
    return y_lat, y_ctx


def sq_relu_mlp(h, w1, w2):
    return jnp.square(jax.nn.relu(h @ w1)) @ w2


def setup_inputs(seed: int = 0) -> dict:
    key = jax.random.key(seed)
    ks = iter(jax.random.split(key, 64))
    n_even = (DEPTH + 1) // 2
    n_odd = DEPTH // 2

    def nrm(shape, scale):
        return jax.random.normal(next(ks), shape, F32) * scale

    def gain(shape):
        return 1.0 + nrm(shape, 0.05)

    f_bias = jnp.broadcast_to(jnp.linspace(3.0, 6.0, ML_HEADS, dtype=F32), (n_odd, ML_HEADS))
    ml_gate_b = jnp.concatenate([nrm((n_odd, ML_HEADS), 0.1), f_bias + nrm((n_odd, ML_HEADS), 0.1),
                                 nrm((n_odd, ML_HEADS), 0.1), f_bias + nrm((n_odd, ML_HEADS), 0.1)], axis=-1)
    return {
        "x": nrm((BATCH, SEQ, D_MODEL), 1.0),
        "c": nrm((BATCH, D_MODEL), 1.0),
        "ctx": nrm((BATCH, CTX_LEN, D_MODEL), 1.0),
        "c_ctx": nrm((D_MODEL,), 1.0),
        "ada_w": nrm((DEPTH, D_MODEL, 6 * D_MODEL), 0.5 * D_MODEL ** -0.5),
        "ada_b": nrm((DEPTH, 6 * D_MODEL), 0.02),
        "g_pre_mix": gain((DEPTH, D_MODEL)),
        "g_post_mix": gain((DEPTH, D_MODEL)),
        "g_pre_ffn": gain((DEPTH, D_MODEL)),
        "g_post_ffn": gain((DEPTH, D_MODEL)),
        "ffn_w1": nrm((DEPTH, D_MODEL, D_FF), D_MODEL ** -0.5),
        "ffn_w2": nrm((DEPTH, D_FF, D_MODEL), D_FF ** -0.5),
        "hy_w_in": nrm((n_even, D_MODEL, HY_IN), D_MODEL ** -0.5),
        "hy_w_out": nrm((n_even, HY_OUT, D_MODEL), HY_OUT ** -0.5),
        "diff_lq1": nrm((n_even, DIFF_DH), 0.1),
        "diff_lk1": nrm((n_even, DIFF_DH), 0.1),
        "diff_lq2": nrm((n_even, DIFF_DH), 0.1),
        "diff_lk2": nrm((n_even, DIFF_DH), 0.1),
        "diff_subln_g": gain((n_even, DIFF_DV)),
        "conv_w": nrm((n_even, CONV_W, CONV_CH), CONV_W ** -0.5),
        "conv_b": nrm((n_even, CONV_CH), 0.02),
        "conv_ln_g": gain((n_even, CONV_CH)),
        "conv_ln_b": nrm((n_even, CONV_CH), 0.02),
        "ml_w_in": nrm((n_odd, D_MODEL, ML_IN), D_MODEL ** -0.5),
        "ml_conv_w": nrm((n_odd, ML_CONV_W, 2 * ML_QK_W), ML_CONV_W ** -0.5),
        "ml_conv_b": nrm((n_odd, 2 * ML_QK_W), 0.02),
        "ml_gate_b": ml_gate_b,
        "ml_norm_g": gain((n_odd, ML_HEADS, ML_DV)),
        "ml_w_out": nrm((n_odd, ML_V_W, D_MODEL), ML_V_W ** -0.5),
    }


def reference(x, c, ctx, c_ctx, ada_w, ada_b, g_pre_mix, g_post_mix, g_pre_ffn, g_post_ffn, ffn_w1, ffn_w2,
              hy_w_in, hy_w_out, diff_lq1, diff_lk1, diff_lq2, diff_lk2, diff_subln_g, conv_w, conv_b,
              conv_ln_g, conv_ln_b, ml_w_in, ml_conv_w, ml_conv_b, ml_gate_b, ml_norm_g, ml_w_out):
    xl, xc = x, ctx
    for l in range(DEPTH):
        need_ctx = l < DEPTH - 1
        mod_l = jnp.split((jax.nn.silu(c) @ ada_w[l] + ada_b[l])[:, None, :], 6, axis=-1)
        mod_c = jnp.split(jax.nn.silu(c_ctx) @ ada_w[l] + ada_b[l], 6, axis=-1)
        hl = modulate(rms_norm(xl, g_pre_mix[l]), mod_l[0], mod_l[1])
        hc = modulate(rms_norm(xc, g_pre_mix[l]), mod_c[0], mod_c[1])
        if l % 2 == 0:
            e = l // 2
            lam_init = 0.8 - 0.6 * math.exp(-0.3 * l)
            yl, yc = hybrid_mixer(hl, hc, hy_w_in[e], hy_w_out[e], diff_lq1[e], diff_lk1[e], diff_lq2[e],
                                  diff_lk2[e], diff_subln_g[e], conv_w[e], conv_b[e], conv_ln_g[e], conv_ln_b[e],
                                  lam_init, need_ctx)
        else:
            o = l // 2
            yl, yc = mlstm_mixer(hl, hc, ml_w_in[o], ml_conv_w[o], ml_conv_b[o], ml_gate_b[o], ml_norm_g[o],
                                 ml_w_out[o], need_ctx)
        xl = xl + mod_l[2] * rms_norm(yl, g_post_mix[l])
        hl = modulate(rms_norm(xl, g_pre_ffn[l]), mod_l[3], mod_l[4])
        xl = xl + mod_l[5] * rms_norm(sq_relu_mlp(hl, ffn_w1[l], ffn_w2[l]), g_post_ffn[l])
        if need_ctx:
            xc = xc + mod_c[2] * rms_norm(yc, g_post_mix[l])
            hc = modulate(rms_norm(xc, g_pre_ffn[l]), mod_c[3], mod_c[4])
            xc = xc + mod_c[5] * rms_norm(sq_relu_mlp(hc, ffn_w1[l], ffn_w2[l]), g_post_ffn[l])
    return xl
```

```cpp
#include <hip/hip_runtime.h>
#include <hip/hip_cooperative_groups.h>
#include <cstdio>
#include <cstdint>
namespace cg = cooperative_groups;
namespace pg8 {
#define PG8_LAS __attribute__((address_space(3)))
typedef unsigned short bf16_t;
typedef short bf16x8 __attribute__((ext_vector_type(8)));
typedef float f32x4 __attribute__((ext_vector_type(4)));
typedef unsigned u32x4 __attribute__((ext_vector_type(4)));
constexpr int BM = 256, BK = 64, HALF = 128, HTB = HALF * BK * 2  , STAGE_BYTES = 8 * HTB, NXCD = 8, WGM = 8;

__host__ __device__ __forceinline__ int lds_byte(int r, int c) { const int st = (r >> 4) * 2 + (c >> 5), rr = r & 15, cc = c & 31, ob = rr * 64 + cc * 2; return st * 1024 + (ob ^ (((ob >> 9) & 1) << 5)); }
__host__ __device__ __forceinline__ void stage_rc(int b, int& R, int& C) { const int st = b / 1024, sb = b % 1024, swz = sb ^ (((sb >> 9) & 1) << 5); R = (st >> 1) * 16 + swz / 64; C = (st & 1) * 32 + (swz % 64) / 2; }
__host__ __device__ __forceinline__ int perm32(int rho) { const int n = rho >> 4, i = rho & 15; return 8 * (i >> 2) + 4 * n + (i & 3); }

struct Unit { int pm, pn; };
struct Gemm { const bf16_t* A; const bf16_t* Bt; int M, N, K; };

struct StaticOrder {
    int nM, nN, nwg, G, c;
    __host__ __device__ void init(int M, int N, int G_, int c_) { nM = M / BM; nN = N / BM; nwg = nM * nN; G = G_; c = c_; }
    __host__ __device__ bool next(int i, Unit& u) const {
        const long L = (long)i * G + c; if (L >= nwg) return false;
        int wgid = (int)L; { const int q = nwg / NXCD, r = nwg % NXCD, xcd = wgid % NXCD, off = wgid / NXCD; wgid = (xcd < r ? xcd * (q + 1) : r * (q + 1) + (xcd - r) * q) + off; }
        const int nig = WGM * nN, gid = wgid / nig, fm = gid * WGM, gsz = (nM - fm) < WGM ? (nM - fm) : WGM;
        u.pm = fm + ((wgid % nig) % gsz); u.pn = (wgid % nig) / gsz; return true;
    }
    __device__ __forceinline__ void a_ready(const Unit&) const {}
    __device__ __forceinline__ void done(const Unit&) const {}
};

__device__ __forceinline__ unsigned cvt_pk_bf16(float lo, float hi) { unsigned r; asm volatile("v_cvt_pk_bf16_f32 %0, %1, %2" : "=v"(r) : "v"(lo), "v"(hi)); return r; }
typedef float f32x2 __attribute__((ext_vector_type(2)));
template <class Epi, class Sched, bool ALIGN_EPI = false, bool SP2 = false>
__device__ __forceinline__ void gemm_phase(PG8_LAS unsigned char* lds, const Gemm g, const Sched& S, const Epi& E) {
    const int tid = threadIdx.x, wid = __builtin_amdgcn_readfirstlane(tid >> 6), lane = tid & 63, wr = wid >> 2, wc = wid & 3, fr = lane & 15, fq = lane >> 4;
    const int K = g.K, nt = K / BK;
    unsigned voffA[2], voffB[2];
#pragma unroll
    for (int i = 0; i < 2; ++i) { int R, C; stage_rc(tid * 16 + i * 8192, R, C); const int Rb = Epi::PERM ? ((R & ~31) + perm32(R & 31)) : R;
        voffA[i] = (unsigned)(R * K + C) * 2u; voffB[i] = (unsigned)(Rb * K + C) * 2u; }
    const size_t kstep = (size_t)(BK * 2);
    const size_t hstep = (size_t)HALF * K * 2;
    const size_t tstep = 2 * hstep;
    const unsigned ldsw = (unsigned)wid * 1024u;
    const int aoff = lds_byte(wr * 64 + fr, fq * 8), boff = lds_byte(wc * 32 + fr, fq * 8);
#define PG8_SA(b, h) (((b) * 2 + (h)) * HTB)
#define PG8_SB(b, h) ((4 + (b) * 2 + (h)) * HTB)
#define PG8_STAGE(bufoff, gbase, voff) do { _Pragma("unroll") for (int _i = 0; _i < 2; ++_i) \
        __builtin_amdgcn_global_load_lds((const unsigned*)((const char*)(gbase) + (voff)[_i]), (PG8_LAS unsigned*)(lds + (bufoff) + ldsw + _i * 8192), 16, 0, 0); } while (0)
#define PG8_LDA(dst, b, h) do { _Pragma("unroll") for (int m = 0; m < 4; ++m) _Pragma("unroll") for (int k = 0; k < 2; ++k) dst[m][k] = *(const PG8_LAS bf16x8*)(lds + PG8_SA(b, h) + aoff + m * 2048 + k * 1024); } while (0)
#define PG8_LDB(dst, b, h) do { _Pragma("unroll") for (int n = 0; n < 2; ++n) _Pragma("unroll") for (int k = 0; k < 2; ++k) dst[n][k] = *(const PG8_LAS bf16x8*)(lds + PG8_SB(b, h) + boff + n * 2048 + k * 1024); } while (0)
#define PG8_MMA(ai, bj, At, Bt) do { __builtin_amdgcn_s_setprio(1); _Pragma("unroll") for (int m = 0; m < 4; ++m) _Pragma("unroll") for (int n = 0; n < 2; ++n) _Pragma("unroll") for (int k = 0; k < 2; ++k) \
        acc[ai][bj][m][n] = __builtin_amdgcn_mfma_f32_16x16x32_bf16(Bt[n][k], At[m][k], acc[ai][bj][m][n], 0, 0, 0); __builtin_amdgcn_s_setprio(0); } while (0)
#define PG8_WAIT_V(n) asm volatile("s_waitcnt vmcnt(" #n ")" ::: "memory")
#define PG8_WAIT_L(n) asm volatile("s_waitcnt lgkmcnt(" #n ")" ::: "memory")
#define PG8_BAR __builtin_amdgcn_s_barrier()
#define PG8_SCHED __builtin_amdgcn_sched_barrier(0)
    Unit cur, nxt; int ui = 0;
    if (!S.next(0, cur)) return;
    f32x4 acc[2][2][4][2];
#pragma unroll
    for (int a = 0; a < 2; ++a)
#pragma unroll
        for (int b = 0; b < 2; ++b)
#pragma unroll
            for (int m = 0; m < 4; ++m)
#pragma unroll
                for (int n = 0; n < 2; ++n) acc[a][b][m][n] = (f32x4){0.f, 0.f, 0.f, 0.f};
    bf16x8 At[4][2], B0[2][2], B1[2][2];
    const char* cA = (const char*)g.A + (size_t)cur.pm * tstep; const char* cB = (const char*)g.Bt + (size_t)cur.pn * tstep;
    S.a_ready(cur);
    if constexpr (SP2) {
        PG8_STAGE(PG8_SB(0, 0), cB, voffB); PG8_STAGE(PG8_SB(0, 1), cB + hstep, voffB); PG8_STAGE(PG8_SA(0, 0), cA, voffA); PG8_STAGE(PG8_SA(0, 1), cA + hstep, voffA);
        if (wr == 1) PG8_BAR;
        PG8_WAIT_V(2); PG8_BAR;
        PG8_STAGE(PG8_SB(1, 0), cB + kstep, voffB); PG8_STAGE(PG8_SA(1, 0), cA + kstep, voffA); PG8_STAGE(PG8_SB(1, 1), cB + hstep + kstep, voffB);
        PG8_WAIT_V(6); PG8_BAR;
    } else {
        PG8_STAGE(PG8_SB(0, 0), cB, voffB); PG8_STAGE(PG8_SA(0, 0), cA, voffA); PG8_STAGE(PG8_SB(0, 1), cB + hstep, voffB); PG8_STAGE(PG8_SA(0, 1), cA + hstep, voffA);
        if (wr == 1) PG8_BAR;
        PG8_WAIT_V(4); PG8_BAR;
        PG8_STAGE(PG8_SB(1, 0), cB + kstep, voffB); PG8_STAGE(PG8_SA(1, 0), cA + kstep, voffA); PG8_STAGE(PG8_SB(1, 1), cB + hstep + kstep, voffB);
        PG8_WAIT_V(6); PG8_BAR;
    }
    for (;;) {
        const bool has_next = S.next(ui + 1, nxt);
        const char* nA = has_next ? (const char*)g.A + (size_t)nxt.pm * tstep : cA; const char* nB = has_next ? (const char*)g.Bt + (size_t)nxt.pn * tstep : cB;
        for (int t = 0; t < nt; t += 2) {
            const bool last = (t == nt - 2);
            const char* a1 = cA + (size_t)(t + 1) * kstep;
            const char* a2 = last ? nA : cA + (size_t)(t + 2) * kstep; const char* b2 = last ? nB : cB + (size_t)(t + 2) * kstep;
            const char* a3 = a2 + kstep; const char* b3 = b2 + kstep;
            if (last && has_next) S.a_ready(nxt);
            if constexpr (SP2) {
            PG8_LDB(B0, 0, 0); PG8_LDB(B1, 0, 1); PG8_SCHED; PG8_LDA(At, 0, 0); PG8_STAGE(PG8_SA(1, 1), a1 + hstep, voffA);
            PG8_WAIT_V(8); PG8_WAIT_L(0); PG8_BAR; PG8_MMA(0, 0, At, B0); PG8_MMA(0, 1, At, B1); PG8_BAR; PG8_SCHED;
            PG8_LDA(At, 0, 1); PG8_STAGE(PG8_SB(0, 0), b2, voffB); PG8_STAGE(PG8_SB(0, 1), b2 + hstep, voffB); PG8_STAGE(PG8_SA(0, 0), a2, voffA);
            PG8_WAIT_V(8); PG8_WAIT_L(0); PG8_BAR; PG8_MMA(1, 0, At, B0); PG8_MMA(1, 1, At, B1); PG8_BAR; PG8_SCHED;
            PG8_LDB(B0, 1, 0); PG8_LDB(B1, 1, 1); PG8_SCHED; PG8_LDA(At, 1, 0); PG8_STAGE(PG8_SA(0, 1), a2 + hstep, voffA);
            PG8_WAIT_V(8); PG8_WAIT_L(0); PG8_BAR; PG8_MMA(0, 0, At, B0); PG8_MMA(0, 1, At, B1); PG8_BAR; PG8_SCHED;
            PG8_LDA(At, 1, 1); PG8_STAGE(PG8_SB(1, 0), b3, voffB); PG8_STAGE(PG8_SB(1, 1), b3 + hstep, voffB); PG8_STAGE(PG8_SA(1, 0), a3, voffA);
            PG8_WAIT_V(8); PG8_WAIT_L(0); PG8_BAR; PG8_MMA(1, 0, At, B0); PG8_MMA(1, 1, At, B1); PG8_BAR; PG8_SCHED;
            } else {
            PG8_LDB(B0, 0, 0); PG8_SCHED; PG8_LDA(At, 0, 0); PG8_STAGE(PG8_SA(1, 1), a1 + hstep, voffA);
            PG8_WAIT_L(8); PG8_BAR; PG8_WAIT_L(0); PG8_MMA(0, 0, At, B0); PG8_BAR; PG8_SCHED;
            PG8_LDB(B1, 0, 1); PG8_STAGE(PG8_SB(0, 0), b2, voffB);
            PG8_BAR; PG8_WAIT_L(0); PG8_MMA(0, 1, At, B1); PG8_BAR;
            PG8_LDA(At, 0, 1); PG8_STAGE(PG8_SA(0, 0), a2, voffA);
            PG8_BAR; PG8_WAIT_L(0); PG8_MMA(1, 0, At, B0); PG8_BAR; PG8_SCHED;
            PG8_STAGE(PG8_SB(0, 1), b2 + hstep, voffB);
            PG8_WAIT_V(6); PG8_BAR; PG8_MMA(1, 1, At, B1); PG8_BAR;
            PG8_LDB(B0, 1, 0); PG8_SCHED; PG8_LDA(At, 1, 0); PG8_STAGE(PG8_SA(0, 1), a2 + hstep, voffA);
            PG8_WAIT_L(8); PG8_BAR; PG8_WAIT_L(0); PG8_MMA(0, 0, At, B0); PG8_BAR; PG8_SCHED;
            PG8_LDB(B1, 1, 1); PG8_STAGE(PG8_SB(1, 0), b3, voffB);
            PG8_BAR; PG8_WAIT_L(0); PG8_MMA(0, 1, At, B1); PG8_BAR;
            PG8_LDA(At, 1, 1); PG8_STAGE(PG8_SA(1, 0), a3, voffA);
            PG8_BAR; PG8_WAIT_L(0); PG8_MMA(1, 0, At, B0); PG8_BAR; PG8_SCHED;
            PG8_STAGE(PG8_SB(1, 1), b3 + hstep, voffB);
            PG8_WAIT_V(6); PG8_BAR; PG8_MMA(1, 1, At, B1); PG8_BAR;
            }
        }
        if constexpr (ALIGN_EPI) { if (wr == 0) PG8_BAR; }
        if constexpr (!Epi::AFTER_DRAIN) { E(acc, cur, wr, wc, fr, fq); S.done(cur); }
        if (!has_next) break;
#pragma unroll
        for (int a = 0; a < 2; ++a)
#pragma unroll
            for (int b = 0; b < 2; ++b)
#pragma unroll
                for (int m = 0; m < 4; ++m)
#pragma unroll
                    for (int n = 0; n < 2; ++n) acc[a][b][m][n] = (f32x4){0.f, 0.f, 0.f, 0.f};
        cur = nxt; cA = nA; cB = nB; ++ui;
        if constexpr (ALIGN_EPI) { if (wr == 1) PG8_BAR; }
    }
    PG8_WAIT_V(0);
    if constexpr (!ALIGN_EPI) { if (wr == 0) PG8_BAR; }
    PG8_BAR;
    if constexpr (Epi::AFTER_DRAIN) { E.fused(acc, cur, wr, wc, fr, fq, lds, wid, lane); S.done(cur); }
#undef PG8_SA
#undef PG8_SB
#undef PG8_STAGE
#undef PG8_LDA
#undef PG8_LDB
#undef PG8_MMA
#undef PG8_WAIT_V
#undef PG8_WAIT_L
#undef PG8_BAR
#undef PG8_SCHED
}
typedef unsigned u32x2 __attribute__((ext_vector_type(2)));
__device__ __forceinline__ unsigned pkbf(float lo, float hi) { typedef float f2 __attribute__((ext_vector_type(2))); typedef __bf16 b2 __attribute__((ext_vector_type(2))); f2 v = {lo, hi}; b2 b = __builtin_convertvector(v, b2); return __builtin_bit_cast(unsigned, b); }
__device__ __forceinline__ u32x4 pk8(const f32x4 v0, const f32x4 v1) { u32x4 w; w.x = pkbf(v0[0], v0[1]); w.y = pkbf(v0[2], v0[3]); w.z = pkbf(v1[0], v1[1]); w.w = pkbf(v1[2], v1[3]); return w; }
__device__ __forceinline__ float sigm(float x) { return 1.0f / (1.0f + __expf(-x)); }
struct EpiF32 {
    static constexpr bool PERM = false, AFTER_DRAIN = false;
    float* O; int ldc;
    __device__ __forceinline__ void operator()(const f32x4 (&acc)[2][2][4][2], const Unit& u, int wr, int wc, int fr, int fq) const {
        const int row0 = u.pm * BM + wr * 64 + fr, col0 = u.pn * BM + wc * 32 + 4 * fq;
#pragma unroll
        for (int ai = 0; ai < 2; ++ai)
#pragma unroll
            for (int m = 0; m < 4; ++m) { float* rowp = O + (size_t)(row0 + ai * HALF + m * 16) * ldc + col0;
#pragma unroll
                for (int bj = 0; bj < 2; ++bj)
#pragma unroll
                    for (int n = 0; n < 2; ++n) *(f32x4*)(rowp + bj * HALF + n * 16) = acc[ai][bj][m][n]; }
    }
};
struct EpiRelu2 {
    static constexpr bool PERM = true, AFTER_DRAIN = false;
    bf16_t* O; int ldc;
    __device__ __forceinline__ void operator()(const f32x4 (&acc)[2][2][4][2], const Unit& u, int wr, int wc, int fr, int fq) const {
        const int row0 = u.pm * BM + wr * 64 + fr, col0 = u.pn * BM + wc * 32 + 8 * fq;
#pragma unroll
        for (int ai = 0; ai < 2; ++ai)
#pragma unroll
            for (int m = 0; m < 4; ++m) { bf16_t* rowp = O + (size_t)(row0 + ai * HALF + m * 16) * ldc + col0;
#pragma unroll
                for (int bj = 0; bj < 2; ++bj) { f32x4 v0 = acc[ai][bj][m][0], v1 = acc[ai][bj][m][1];
#pragma unroll
                    for (int e = 0; e < 4; ++e) { const float a = fmaxf(v0[e], 0.f), b = fmaxf(v1[e], 0.f); v0[e] = a * a; v1[e] = b * b; }
                    *(u32x4*)(rowp + bj * HALF) = pk8(v0, v1); } }
    }
};
struct EpiHyIn {
    static constexpr bool PERM = true, AFTER_DRAIN = false;
    bf16_t *Qb, *Vb, *UG; size_t sec; const float* rope;
    __device__ __forceinline__ void operator()(const f32x4 (&acc)[2][2][4][2], const Unit& u, int wr, int wc, int fr, int fq) const {
        const int pn = u.pn, row0 = u.pm * BM + wr * 64 + fr, cbase = wc * 32 + 8 * fq;
        if (pn < 8) {
            bf16_t* base = Qb + (size_t)(pn >> 2) * sec + (pn & 3) * 256 + cbase; const bool rope_on = u.pm < 64;
#pragma unroll
            for (int ai = 0; ai < 2; ++ai)
#pragma unroll
                for (int m = 0; m < 4; ++m) { const int row = row0 + ai * HALF + m * 16;
                    f32x4 cs0 = {1.f, 0.f, 1.f, 0.f}, cs1 = {1.f, 0.f, 1.f, 0.f};
                    if (rope_on) { const int t = row & 4095, pos = (wc & 1) ? (t & 63) : (t >> 6); const f32x4* tp = (const f32x4*)(rope + (pos * 16 + 4 * fq) * 2); cs0 = tp[0]; cs1 = tp[1]; }
#pragma unroll
                    for (int bj = 0; bj < 2; ++bj) { const f32x4 v0 = acc[ai][bj][m][0], v1 = acc[ai][bj][m][1]; f32x4 o0, o1;
                        o0[0] = v0[0] * cs0[0] - v0[1] * cs0[1]; o0[1] = v0[1] * cs0[0] + v0[0] * cs0[1];
                        o0[2] = v0[2] * cs0[2] - v0[3] * cs0[3]; o0[3] = v0[3] * cs0[2] + v0[2] * cs0[3];
                        o1[0] = v1[0] * cs1[0] - v1[1] * cs1[1]; o1[1] = v1[1] * cs1[0] + v1[0] * cs1[1];
                        o1[2] = v1[2] * cs1[2] - v1[3] * cs1[3]; o1[3] = v1[3] * cs1[2] + v1[2] * cs1[3];
                        *(u32x4*)(base + (size_t)row * 1024 + bj * HALF) = pk8(o0, o1); } }
        } else if (pn < 12) {
            bf16_t* base = Vb + (pn - 8) * 256 + cbase;
#pragma unroll
            for (int ai = 0; ai < 2; ++ai)
#pragma unroll
                for (int m = 0; m < 4; ++m) { const int row = row0 + ai * HALF + m * 16;
#pragma unroll
                    for (int bj = 0; bj < 2; ++bj) *(u32x4*)(base + (size_t)row * 1024 + bj * HALF) = pk8(acc[ai][bj][m][0], acc[ai][bj][m][1]); }
        } else {
            bf16_t* base = UG + ((pn - 12) * 256 + cbase) / 2;
#pragma unroll
            for (int ai = 0; ai < 2; ++ai)
#pragma unroll
                for (int m = 0; m < 4; ++m) { const int row = row0 + ai * HALF + m * 16;
#pragma unroll
                    for (int bj = 0; bj < 2; ++bj) { const f32x4 v0 = acc[ai][bj][m][0], v1 = acc[ai][bj][m][1];
                        u32x2 w; w.x = pkbf(v0[0] * sigm(v0[1]), v0[2] * sigm(v0[3])); w.y = pkbf(v1[0] * sigm(v1[1]), v1[2] * sigm(v1[3]));
                        *(u32x2*)(base + (size_t)row * 1024 + bj * 64) = w; } }
        }
    }
};
struct EpiMlIn {
    static constexpr bool PERM = true, AFTER_DRAIN = false;
    bf16_t* QK; size_t sec; float* G;
    __device__ __forceinline__ void operator()(const f32x4 (&acc)[2][2][4][2], const Unit& u, int wr, int wc, int fr, int fq) const {
        const int pn = u.pn, row0 = u.pm * BM + wr * 64 + fr, cbase = wc * 32 + 8 * fq;
        if (pn < 24) {
            bf16_t* base = QK + (size_t)(pn >> 3) * sec + (pn & 7) * 256 + cbase;
#pragma unroll
            for (int ai = 0; ai < 2; ++ai)
#pragma unroll
                for (int m = 0; m < 4; ++m) { const int row = row0 + ai * HALF + m * 16;
#pragma unroll
                    for (int bj = 0; bj < 2; ++bj) *(u32x4*)(base + (size_t)row * 2048 + bj * HALF) = pk8(acc[ai][bj][m][0], acc[ai][bj][m][1]); }
        } else if (wc == 0) {
#pragma unroll
            for (int ai = 0; ai < 2; ++ai)
#pragma unroll
                for (int m = 0; m < 4; ++m) { const int row = row0 + ai * HALF + m * 16; float* gp = G + (size_t)row * 32 + 8 * fq;
                    *(f32x4*)gp = acc[ai][0][m][0]; *(f32x4*)(gp + 4) = acc[ai][0][m][1]; }
        }
    }
};
}
#define LAS __attribute__((address_space(3)))
typedef unsigned short bf16;
typedef float f32x4 __attribute__((ext_vector_type(4)));
typedef unsigned u32x4 __attribute__((ext_vector_type(4)));
typedef unsigned u32x2 __attribute__((ext_vector_type(2)));
typedef short bf16x8 __attribute__((ext_vector_type(8)));
constexpr int DM = 2048, NB = 4, SEQL = 4096, CTXL = 256, MLAT = NB * SEQL, MCTX = NB * CTXL, MTOT = MLAT + MCTX, DFF = 8192;
constexpr float EPSN = 1e-6f;
constexpr size_t MiB = 1u << 20;
constexpr size_t WS_MOD = 0, WS_ROPE = 512 * 1024, WS_FFN1_0 = 1 * MiB, WS_FFN2_0 = 33 * MiB, WS_FFN1_1 = 65 * MiB, WS_FFN2_1 = 97 * MiB, WS_HYIN = 129 * MiB, WS_HYOUT = 149 * MiB,
                 WS_MLIN = 157 * MiB, WS_MLOUT = 182 * MiB, WS_XC = 190 * MiB, WS_H = 198 * MiB, WS_Y = 266 * MiB, WS_R = 402 * MiB,
                 WS_Q = WS_R, WS_K = WS_R + 34 * MiB, WS_V = WS_R + 68 * MiB, WS_UG = WS_R + 102 * MiB, WS_AO = WS_R + 136 * MiB, WS_HFF = WS_R,
                 WS_QKRAW = WS_R, WS_HF = WS_R, WS_V1 = WS_R + 68 * MiB, WS_AO1 = WS_R + 68 * MiB, WS_O1 = WS_R + 136 * MiB, WS_QKC = WS_R + 204 * MiB, WS_HB = WS_R + 272 * MiB,
                 WS_G = WS_R + 336 * MiB, WS_END = WS_R + 339 * MiB;
constexpr int MODSZ = 5 * 12288;
constexpr int LDS_BYTES = 135168;

struct Params { const float* in[29]; float* out; unsigned char* ws; int ph_lo, ph_hi; };

__device__ __forceinline__ unsigned pk2(float lo, float hi) { typedef float f2 __attribute__((ext_vector_type(2))); typedef __bf16 b2 __attribute__((ext_vector_type(2))); f2 v = {lo, hi}; b2 b = __builtin_convertvector(v, b2); return __builtin_bit_cast(unsigned, b); }
__device__ __forceinline__ float bflo(unsigned w) { return __uint_as_float(w << 16); }
__device__ __forceinline__ float bfhi(unsigned w) { return __uint_as_float(w & 0xffff0000u); }
__device__ __forceinline__ float bf1(bf16 b) { return __uint_as_float((unsigned)b << 16); }
__device__ __forceinline__ float wave_sum(float v) {
#pragma unroll
    for (int o = 1; o < 64; o <<= 1) v += __shfl_xor(v, o);
    return v;
}
__device__ __forceinline__ float sigmf(float x) { return 1.0f / (1.0f + __expf(-x)); }

__device__ __forceinline__ int dst_row(int mode, int n) {
    if (mode == 1) {
        if (n < 2048) { const int d = n & 63, q = d >> 4, i = d & 15; const int dp = (q >> 1) * 32 + 2 * i + (q & 1); return (n & ~63) | dp; }
        if (n < 3072) return n;
        const int uu = n - 3072; return 3072 + 2 * (uu & 1023) + (uu >> 10);
    }
    if (mode == 2) {
        if (n < 4096) return n;
        if (n < 4128) return 6144 + (n - 4096);
        return 4096 + (n - 4128);
    }
    return n;
}
__device__ __forceinline__ void transpose_item(const float* W, int K, int N, bf16* WT, int mode, LAS float* scr, int item, int lane) {
    const int nblk = (N + 31) / 32, kb = item / nblk, nb = item % nblk, k0 = 64 * kb, n0 = 32 * nb;
#pragma unroll 8
    for (int i = 0; i < 32; ++i) { const int kk = 2 * i + (lane >> 5); scr[kk * 33 + (lane & 31)] = W[(size_t)(k0 + kk) * N + n0 + (lane & 31)]; }
    asm volatile("s_waitcnt lgkmcnt(0)" ::: "memory");
    const int c = lane & 7;
#pragma unroll
    for (int j = 0; j < 4; ++j) { const int n = (lane >> 3) + 8 * j; const LAS float* s = scr + (8 * c) * 33 + n;
        u32x4 o; o.x = pk2(s[0 * 33], s[1 * 33]); o.y = pk2(s[2 * 33], s[3 * 33]); o.z = pk2(s[4 * 33], s[5 * 33]); o.w = pk2(s[6 * 33], s[7 * 33]);
        *(u32x4*)(WT + (size_t)dst_row(mode, n0 + n) * K + k0 + 8 * c) = o; }
    asm volatile("s_waitcnt lgkmcnt(0)" ::: "memory");
}
__device__ __forceinline__ void ph_prologue(const Params& p, LAS unsigned char* lds) {
    const int tid = threadIdx.x, lane = tid & 63, wave = tid >> 6;
    const int gw = blockIdx.x * 8 + wave, NGW = gridDim.x * 8;
    LAS float* sl = (LAS float*)lds;
    LAS float* scr = (LAS float*)(lds + 40960 + wave * 8448);
    for (int i = tid; i < 5 * 2048; i += 512) { const int s = i >> 11, k = i & 2047; const float v = s < 4 ? p.in[1][s * 2048 + k] : p.in[3][k]; sl[i] = v / (1.0f + __expf(-v)); }
    if (blockIdx.x == 0) {
        float* rope = (float*)(p.ws + WS_ROPE);
        for (int i = tid; i < 1024; i += 512) { const int pos = i >> 4, fi = i & 15; const double x = (double)exp2f(-(float)fi * 0.83048202372184058696f);
            double s = 0.0, c = 0.0, ts = x, tc = 1.0; const double x2 = x * x;
            for (int n = 0; n < 12; ++n) { c += tc; s += ts; tc = -tc * x2 / (double)((2 * n + 1) * (2 * n + 2)); ts = -ts * x2 / (double)((2 * n + 2) * (2 * n + 3)); }
            double cr = 1.0, sr = 0.0; for (int q = 0; q < pos; ++q) { const double nc = cr * c - sr * s, ns = sr * c + cr * s; cr = nc; sr = ns; }
            rope[2 * i] = (float)cr; rope[2 * i + 1] = (float)sr; }
    }
    __syncthreads();
    float* MOD = (float*)(p.ws + WS_MOD);
    for (int it = gw; it < 2 * 192 * 16; it += NGW) {
        const int l = it / 3072, r = it % 3072, ng = r >> 4, kc = r & 15, n = ng * 64 + lane;
        const float* W = p.in[4] + (size_t)l * 2048 * 12288 + (size_t)(kc * 128) * 12288 + n;
        float a0 = 0.f, a1 = 0.f, a2 = 0.f, a3 = 0.f, a4 = 0.f;
#pragma unroll 8
        for (int k = 0; k < 128; ++k) { const float w = W[(size_t)k * 12288]; const int kk = kc * 128 + k;
            a0 += sl[kk] * w; a1 += sl[2048 + kk] * w; a2 += sl[4096 + kk] * w; a3 += sl[6144 + kk] * w; a4 += sl[8192 + kk] * w; }
        if (kc == 0) { const float b = p.in[5][l * 12288 + n]; a0 += b; a1 += b; a2 += b; a3 += b; a4 += b; }
        float* m = MOD + l * MODSZ + n;
        __hip_atomic_fetch_add(m, a0, __ATOMIC_RELAXED, __HIP_MEMORY_SCOPE_AGENT); __hip_atomic_fetch_add(m + 12288, a1, __ATOMIC_RELAXED, __HIP_MEMORY_SCOPE_AGENT);
        __hip_atomic_fetch_add(m + 2 * 12288, a2, __ATOMIC_RELAXED, __HIP_MEMORY_SCOPE_AGENT); __hip_atomic_fetch_add(m + 3 * 12288, a3, __ATOMIC_RELAXED, __HIP_MEMORY_SCOPE_AGENT);
        __hip_atomic_fetch_add(m + 4 * 12288, a4, __ATOMIC_RELAXED, __HIP_MEMORY_SCOPE_AGENT);
    }
    constexpr int I_F = 8192, I_HI = 5120, I_HO = 2048, I_MI = 32 * 193, I_MO = 2048, NIT = 4 * I_F + I_HI + I_HO + I_MI + I_MO;
    for (int it = gw; it < NIT; it += NGW) {
        int r = it;
        if (r < I_F) { transpose_item(p.in[10], 2048, 8192, (bf16*)(p.ws + WS_FFN1_0), 0, scr, r, lane); continue; } r -= I_F;
        if (r < I_F) { transpose_item(p.in[11], 8192, 2048, (bf16*)(p.ws + WS_FFN2_0), 0, scr, r, lane); continue; } r -= I_F;
        if (r < I_F) { transpose_item(p.in[10] + (size_t)2048 * 8192, 2048, 8192, (bf16*)(p.ws + WS_FFN1_1), 0, scr, r, lane); continue; } r -= I_F;
        if (r < I_F) { transpose_item(p.in[11] + (size_t)2048 * 8192, 8192, 2048, (bf16*)(p.ws + WS_FFN2_1), 0, scr, r, lane); continue; } r -= I_F;
        if (r < I_HI) { transpose_item(p.in[12], 2048, 5120, (bf16*)(p.ws + WS_HYIN), 1, scr, r, lane); continue; } r -= I_HI;
        if (r < I_HO) { transpose_item(p.in[13], 2048, 2048, (bf16*)(p.ws + WS_HYOUT), 0, scr, r, lane); continue; } r -= I_HO;
        if (r < I_MI) { transpose_item(p.in[23], 2048, 6176, (bf16*)(p.ws + WS_MLIN), 2, scr, r, lane); continue; } r -= I_MI;
        transpose_item(p.in[28], 2048, 2048, (bf16*)(p.ws + WS_MLOUT), 0, scr, r, lane);
    }
}

__device__ __forceinline__ void ph_rows(const Params& p, int nrows, bool first, bool has_y, int lcur, int gate_idx, const float* gpost, bool has_next, int lnext, int shift_idx, const float* gnext) {
    const int lane = threadIdx.x & 63, wave = threadIdx.x >> 6, gw = blockIdx.x * 8 + wave, NGW = gridDim.x * 8;
    const float* MOD = (const float*)(p.ws + WS_MOD); const float* Y = (const float*)(p.ws + WS_Y); float* XC = (float*)(p.ws + WS_XC); bf16* H = (bf16*)(p.ws + WS_H);
    for (int r = gw; r < nrows; r += NGW) {
        const bool lat = r < MLAT; const int s = lat ? (r >> 12) : 4;
        const float* xin = lat ? ((first ? p.in[0] : p.out) + (size_t)r * DM) : ((first ? p.in[2] : XC) + (size_t)(r - MLAT) * DM);
        float* xout = lat ? (p.out + (size_t)r * DM) : (XC + (size_t)(r - MLAT) * DM);
        f32x4 v[8];
#pragma unroll
        for (int j = 0; j < 8; ++j) v[j] = *(const f32x4*)(xin + 4 * lane + 256 * j);
        if (has_y) {
            f32x4 y[8]; float ss = 0.f;
#pragma unroll
            for (int j = 0; j < 8; ++j) { y[j] = *(const f32x4*)(Y + (size_t)r * DM + 4 * lane + 256 * j); ss += (y[j][0] * y[j][0] + y[j][1] * y[j][1]) + (y[j][2] * y[j][2] + y[j][3] * y[j][3]); }
            const float rs = rsqrtf(wave_sum(ss) * (1.0f / DM) + EPSN);
            const float* gate = MOD + lcur * MODSZ + s * 12288 + gate_idx * 2048;
#pragma unroll
            for (int j = 0; j < 8; ++j) { const int c = 4 * lane + 256 * j; const f32x4 g = *(const f32x4*)(gate + c), gp = *(const f32x4*)(gpost + c);
                v[j] += g * (y[j] * rs * gp); *(f32x4*)(xout + c) = v[j]; }
        }
        if (has_next) {
            float ss = 0.f;
#pragma unroll
            for (int j = 0; j < 8; ++j) ss += (v[j][0] * v[j][0] + v[j][1] * v[j][1]) + (v[j][2] * v[j][2] + v[j][3] * v[j][3]);
            const float rs = rsqrtf(wave_sum(ss) * (1.0f / DM) + EPSN);
            const float* sh = MOD + lnext * MODSZ + s * 12288 + shift_idx * 2048; const float* sc = sh + 2048;
#pragma unroll
            for (int j = 0; j < 8; ++j) { const int c = 4 * lane + 256 * j; const f32x4 a = *(const f32x4*)(sh + c), b = *(const f32x4*)(sc + c), g = *(const f32x4*)(gnext + c);
                const f32x4 h = (v[j] * rs * g) * (1.0f + b) + a; u32x2 w; w.x = pk2(h[0], h[1]); w.y = pk2(h[2], h[3]); *(u32x2*)(H + (size_t)r * DM + c) = w; }
        }
    }
}
namespace att {
using f32x16 = __attribute__((ext_vector_type(16))) float;
using s16x4 = __attribute__((ext_vector_type(4))) short;
constexpr float SCALE = 0.125f, THR = 8.f;
constexpr int SHM_V = 64 * 128 * 2, SHM_K = 64 * 128 * 2;
#define KSWZ(row, colB) ((row) * 256 + ((colB) ^ (((row) & 7) << 4)))
#define SBAR() __builtin_amdgcn_sched_barrier(0)
__device__ __forceinline__ int crow(int r, int hi) { return (r & 3) + 8 * (r >> 2) + 4 * hi; }
__device__ __forceinline__ unsigned cvtpk(float lo, float hi) { unsigned r; asm volatile("v_cvt_pk_bf16_f32 %0, %1, %2" : "=v"(r) : "v"(lo), "v"(hi)); return r; }
__device__ __forceinline__ void partialSM(f32x16& p0, f32x16& p1, float& m_reg, float& mn, float& alpha) {
  constexpr float C = SCALE * 1.4426950408889634f;
  float pmax = p0[0];
#pragma unroll
  for (int r = 1; r < 16; ++r) pmax = fmaxf(pmax, p0[r]);
#pragma unroll
  for (int r = 0; r < 16; ++r) pmax = fmaxf(pmax, p1[r]);
  { auto rr = __builtin_amdgcn_permlane32_swap(__float_as_uint(pmax), __float_as_uint(pmax), false, false);
    pmax = fmaxf(__uint_as_float(rr[0]), __uint_as_float(rr[1])); }
  if (__builtin_expect(__all(pmax - m_reg <= THR / SCALE), 1)) { mn = m_reg; alpha = 1.f; }
  else { mn = fmaxf(m_reg, pmax); alpha = __builtin_amdgcn_exp2f((m_reg - mn) * C); m_reg = mn; }
  float mnC = -mn * C;
#pragma unroll
  for (int r = 0; r < 16; ++r) p0[r] = fmaf(p0[r], C, mnC);
#pragma unroll
  for (int r = 0; r < 16; ++r) p1[r] = fmaf(p1[r], C, mnC);
#pragma unroll
  for (int r = 0; r < 16; ++r) p0[r] = __builtin_amdgcn_exp2f(p0[r]);
}
__device__ __forceinline__ void finishSM(f32x16& p0, f32x16& p1, float alpha, float& l_reg, bf16x8& pa0, bf16x8& pa1, bf16x8& pa2, bf16x8& pa3) {
#pragma unroll
  for (int r = 0; r < 16; ++r) p1[r] = __builtin_amdgcn_exp2f(p1[r]);
  float ps = 0;
#pragma unroll
  for (int r = 0; r < 16; ++r) ps += p0[r];
#pragma unroll
  for (int r = 0; r < 16; ++r) ps += p1[r];
  { auto rr = __builtin_amdgcn_permlane32_swap(__float_as_uint(ps), __float_as_uint(ps), false, false);
    ps = __uint_as_float(rr[0]) + __uint_as_float(rr[1]); }
  l_reg = l_reg * alpha + ps;
#define PK4(P, BASE, OUT) do { unsigned a0 = cvtpk(P[BASE + 0], P[BASE + 1]), a1 = cvtpk(P[BASE + 2], P[BASE + 3]);   \
    unsigned b0 = cvtpk(P[BASE + 4], P[BASE + 5]), b1 = cvtpk(P[BASE + 6], P[BASE + 7]);                              \
    auto r0 = __builtin_amdgcn_permlane32_swap(a0, b0, false, false); auto r1 = __builtin_amdgcn_permlane32_swap(a1, b1, false, false); \
    u32x4 w = {r0[0], r1[0], r0[1], r1[1]}; OUT = *reinterpret_cast<bf16x8*>(&w); } while (0)
  PK4(p0, 0, pa0); PK4(p0, 8, pa1); PK4(p1, 0, pa2); PK4(p1, 8, pa3);
#undef PK4
}
__device__ __forceinline__ void qkt(f32x16& p0, f32x16& p1, const char* Ks, const bf16x8* qr, int r32, int hi, int comp) {
  p0 = f32x16{}; p1 = f32x16{};
#pragma unroll
  for (int d0 = 0; d0 < 4; ++d0) { const int cb = ((comp * 4 + d0) * 16 + hi * 8) * 2;
    bf16x8 b0 = *reinterpret_cast<const bf16x8*>(Ks + KSWZ(r32, cb));
    bf16x8 b1 = *reinterpret_cast<const bf16x8*>(Ks + KSWZ(32 + r32, cb));
    p0 = __builtin_amdgcn_mfma_f32_32x32x16_bf16(b0, qr[d0], p0, 0, 0, 0);
    p1 = __builtin_amdgcn_mfma_f32_32x32x16_bf16(b1, qr[d0], p1, 0, 0, 0); }
}
__device__ __forceinline__ int v_st(int k, int c) { const int kk = (k & ~0xC) | ((k & 4) << 1) | ((k & 8) >> 1); return ((kk >> 3) * 4 + (c >> 5)) * 512 + ((kk & 7) * 32 + (c & 31)) * 2; }
__device__ __forceinline__ int v_rd_base(int lane) { return ((lane & 3) << 3) | (((lane >> 2) & 3) << 6) | (((lane >> 4) & 1) << 5) | (((lane >> 5) & 1) << 8); }
constexpr int v_rd_off(int d0, int ks, int half) { return d0 * 512 + ks * 4096 + half * 2048; }
template <int OFF> __device__ __forceinline__ s16x4 tr_read(int vb) {
  s16x4 r; asm volatile("ds_read_b64_tr_b16 %0, %1 offset:%2" : "=&v"(r) : "v"(vb), "i"(OFF) : "memory"); return r;
}
template <int D0> __device__ __forceinline__ void pv_one(f32x16& od, int vb, bf16x8 pa0, bf16x8 pa1, bf16x8 pa2, bf16x8 pa3) {
  const s16x4 l0 = tr_read<v_rd_off(D0, 0, 0)>(vb), h0 = tr_read<v_rd_off(D0, 0, 1)>(vb), l1 = tr_read<v_rd_off(D0, 1, 0)>(vb), h1 = tr_read<v_rd_off(D0, 1, 1)>(vb);
  const s16x4 l2 = tr_read<v_rd_off(D0, 2, 0)>(vb), h2 = tr_read<v_rd_off(D0, 2, 1)>(vb), l3 = tr_read<v_rd_off(D0, 3, 0)>(vb), h3 = tr_read<v_rd_off(D0, 3, 1)>(vb);
  asm volatile("s_waitcnt lgkmcnt(0)" ::: "memory"); SBAR();
#define PK(L, H) (bf16x8){L[0], L[1], L[2], L[3], H[0], H[1], H[2], H[3]}
  od = __builtin_amdgcn_mfma_f32_32x32x16_bf16(pa0, PK(l0, h0), od, 0, 0, 0);
  od = __builtin_amdgcn_mfma_f32_32x32x16_bf16(pa1, PK(l1, h1), od, 0, 0, 0);
  od = __builtin_amdgcn_mfma_f32_32x32x16_bf16(pa2, PK(l2, h2), od, 0, 0, 0);
  od = __builtin_amdgcn_mfma_f32_32x32x16_bf16(pa3, PK(l3, h3), od, 0, 0, 0);
#undef PK
}
__device__ __forceinline__ void pv_d0(f32x16* o, int vb, bf16x8 pa0, bf16x8 pa1, bf16x8 pa2, bf16x8 pa3) {
  pv_one<0>(o[0], vb, pa0, pa1, pa2, pa3); pv_one<1>(o[1], vb, pa0, pa1, pa2, pa3); pv_one<2>(o[2], vb, pa0, pa1, pa2, pa3); pv_one<3>(o[3], vb, pa0, pa1, pa2, pa3);
}
__device__ __forceinline__ void attn_unit(const bf16* __restrict__ Qg, const bf16* __restrict__ Kg, const bf16* __restrict__ Vg, bf16* __restrict__ AO,
                                          int b, int h, int qrow0, int NT, float lam, const float* __restrict__ subg, char* lds) {
  const int tid = threadIdx.x, wid = tid >> 6, lane = tid & 63, r32 = lane & 31, hi = lane >> 5, comp = wid >> 2, wq = wid & 3;
  char* V_lds = lds; char* K_lds = lds + 2 * SHM_V;
  float* ws = (float*)(lds + 2 * SHM_V + 2 * SHM_K) + wid * 64; float* li_l = ws; float* al_l = ws + 32;
  float m_reg = -1e30f, l_reg = 0; f32x16 o[4] = {}; bf16x8 qr[4];
  const bf16* Qw = Qg + (size_t)(qrow0 + wq * 32 + r32) * 1024 + h * 128 + comp * 64 + hi * 8;
#pragma unroll
  for (int d0 = 0; d0 < 4; ++d0) qr[d0] = *reinterpret_cast<const bf16x8*>(Qw + d0 * 16);
  const int sr = tid >> 4, sc = (tid & 15) * 8, vst0 = v_st(sr, sc), vst1 = v_st(32 + sr, sc);
  const int vb0 = (int)(uintptr_t)V_lds + v_rd_base(lane);
  struct { bf16x8 vs0, vs1, ks0, ks1; } sr_[2];
  const int kctx = MLAT + b * 256, klat = b * 4096 - 256;
#define KROW(j) (((j) < 4 ? kctx : klat) + (j) * 64)
#define SLOAD(i, j) do { const size_t r0_ = (size_t)(KROW(j) + sr) * 1024 + h * 128 + sc; \
    sr_[i].vs0 = *reinterpret_cast<const bf16x8*>(Vg + r0_); sr_[i].vs1 = *reinterpret_cast<const bf16x8*>(Vg + r0_ + 32 * 1024); \
    sr_[i].ks0 = *reinterpret_cast<const bf16x8*>(Kg + r0_); sr_[i].ks1 = *reinterpret_cast<const bf16x8*>(Kg + r0_ + 32 * 1024); } while (0)
#define SWRITE(bb, i) do { *(bf16x8*)(V_lds + (bb) * SHM_V + vst0) = sr_[i].vs0; *(bf16x8*)(V_lds + (bb) * SHM_V + vst1) = sr_[i].vs1; const int kc = sc * 2; \
    *(bf16x8*)(K_lds + (bb) * SHM_K + KSWZ(sr, kc)) = sr_[i].ks0; *(bf16x8*)(K_lds + (bb) * SHM_K + KSWZ(32 + sr, kc)) = sr_[i].ks1; } while (0)
#define SWAIT() asm volatile("s_waitcnt vmcnt(4)" ::: "memory")
#define RESC(a) do { if (__any((a) < 1.f)) { if (hi == 0) al_l[r32] = (a); asm volatile("s_waitcnt lgkmcnt(0)" ::: "memory"); \
    _Pragma("unroll") for (int d = 0; d < 4; ++d) _Pragma("unroll") for (int r = 0; r < 16; ++r) o[d][r] *= al_l[crow(r, hi)]; } } while (0)
  f32x16 pA0, pA1, pB0, pB1; float mnA, mnB, alA, alB; bf16x8 pa0, pa1, pa2, pa3;
  constexpr int SE = 0, SO = 1;
  SLOAD(SE, 0); asm volatile("s_waitcnt vmcnt(0)" ::: "memory"); SWRITE(0, SE); __syncthreads();
  qkt(pA0, pA1, K_lds, qr, r32, hi, comp); partialSM(pA0, pA1, m_reg, mnA, alA);
  SLOAD(SO, 1); if (2 < NT) SLOAD(SE, 2);
  SWAIT(); SWRITE(1, SO); __syncthreads();
  for (int j = 1; j + 1 < NT; j += 2) {
    SBAR(); qkt(pB0, pB1, K_lds + SHM_K, qr, r32, hi, comp);
    finishSM(pA0, pA1, alA, l_reg, pa0, pa1, pa2, pa3); SBAR();
    SLOAD(SO, j + 2); SBAR();
    pv_d0(o, vb0, pa0, pa1, pa2, pa3); partialSM(pB0, pB1, m_reg, mnB, alB);
    __syncthreads(); SWAIT(); SWRITE(0, SE);
    RESC(alB); __syncthreads();
    SBAR(); qkt(pA0, pA1, K_lds, qr, r32, hi, comp);
    finishSM(pB0, pB1, alB, l_reg, pa0, pa1, pa2, pa3); SBAR();
    if (j + 3 < NT) SLOAD(SE, j + 3); SBAR();
    pv_d0(o, vb0 + SHM_V, pa0, pa1, pa2, pa3); partialSM(pA0, pA1, m_reg, mnA, alA);
    __syncthreads(); SWAIT(); SWRITE(1, SO);
    RESC(alA); __syncthreads();
  }
  SBAR(); qkt(pB0, pB1, K_lds + SHM_K, qr, r32, hi, comp);
  finishSM(pA0, pA1, alA, l_reg, pa0, pa1, pa2, pa3); SBAR();
  pv_d0(o, vb0, pa0, pa1, pa2, pa3); partialSM(pB0, pB1, m_reg, mnB, alB);
  __syncthreads(); RESC(alB);
  finishSM(pB0, pB1, alB, l_reg, pa0, pa1, pa2, pa3); SBAR();
  pv_d0(o, vb0 + SHM_V, pa0, pa1, pa2, pa3);
  if (hi == 0) li_l[r32] = l_reg; asm volatile("s_waitcnt lgkmcnt(0)" ::: "memory");
  float rli[16]; const float sgn = comp ? -lam : 1.0f;
#pragma unroll
  for (int r = 0; r < 16; ++r) rli[r] = __builtin_amdgcn_rcpf(li_l[crow(r, hi)]) * sgn;
  __syncthreads();
  float* ex = (float*)lds + (size_t)wq * 4096 + lane;
  if (comp == 1) {
#pragma unroll
    for (int d0 = 0; d0 < 4; ++d0)
#pragma unroll
      for (int r = 0; r < 16; ++r) ex[(d0 * 16 + r) * 64] = o[d0][r] * rli[r];
  }
  __syncthreads();
  if (comp == 0) {
    float ss[16];
#pragma unroll
    for (int r = 0; r < 16; ++r) { float s = 0.f;
#pragma unroll
      for (int d0 = 0; d0 < 4; ++d0) { const float v = o[d0][r] * rli[r] + ex[(d0 * 16 + r) * 64]; o[d0][r] = v; s += v * v; }
      ss[r] = s; }
#pragma unroll
    for (int off = 1; off < 32; off <<= 1)
#pragma unroll
      for (int r = 0; r < 16; ++r) ss[r] += __shfl_xor(ss[r], off);
    float g[4];
#pragma unroll
    for (int d0 = 0; d0 < 4; ++d0) g[d0] = subg[32 * d0 + r32] * 0.8f;
    bf16* Ow = AO + (size_t)(qrow0 + wq * 32) * 2048 + h * 128 + r32;
#pragma unroll
    for (int r = 0; r < 16; ++r) { const float rs = rsqrtf(ss[r] * (1.0f / 128.f) + EPSN); const int orow = crow(r, hi);
#pragma unroll
      for (int d0 = 0; d0 < 4; ++d0) Ow[(size_t)orow * 2048 + d0 * 32] = (bf16)(pk2(o[d0][r] * rs * g[d0], 0.f) & 0xffffu); }
  }
  __syncthreads();
#undef KROW
#undef SLOAD
#undef SWRITE
#undef SWAIT
#undef RESC
}
#undef SBAR
#undef KSWZ
}

__device__ __forceinline__ void conv_item(const Params& p, int item, char* lds) {
  const int tid = threadIdx.x, lane = tid & 63, wave = tid >> 6, r0 = item * 16, c0 = 2 * tid;
  int s0, s1; if (r0 < MLAT) { s0 = r0 & ~4095; s1 = s0 + 4096; } else { s0 = MLAT + ((r0 - MLAT) & ~255); s1 = s0 + 256; }
  const bf16* UG = (const bf16*)(p.ws + WS_UG); bf16* AO = (bf16*)(p.ws + WS_AO);
  float* red = (float*)lds; float* stat = red + 256;
  float o0[16], o1[16];
#pragma unroll
  for (int t = 0; t < 16; ++t) { o0[t] = 0.f; o1[t] = 0.f; }
  {
    float w0[31], w1[31];
#pragma unroll
    for (int j = 0; j < 31; ++j) { const float2 w = *(const float2*)(p.in[19] + j * 1024 + c0); w0[j] = w.x; w1[j] = w.y; }
#pragma unroll
    for (int rr = 0; rr < 46; ++rr) { const int row = r0 - 15 + rr; unsigned xw = 0u;
      if (row >= s0 && row < s1) xw = *(const unsigned*)(UG + (size_t)row * 1024 + c0);
      const float x0 = bflo(xw), x1 = bfhi(xw);
#pragma unroll
      for (int t = 0; t < 16; ++t) { const int j = rr - t; if (j >= 0 && j <= 30) { o0[t] = fmaf(w0[j], x0, o0[t]); o1[t] = fmaf(w1[j], x1, o1[t]); } } }
  }
  const float2 cb = *(const float2*)(p.in[20] + c0);
  float v[32];
#pragma unroll
  for (int t = 0; t < 16; ++t) { o0[t] += cb.x; o1[t] += cb.y; v[t] = o0[t] + o1[t]; v[16 + t] = o0[t] * o0[t] + o1[t] * o1[t]; }
#pragma unroll
  for (int S = 16; S >= 1; S >>= 1) {
    const bool up = (lane & S) != 0;
#pragma unroll
    for (int k = 0; k < S; ++k) { const float a = v[k], bq = v[k + S]; const float keep = up ? bq : a, send = up ? a : bq; v[k] = keep + __shfl_xor(send, S); }
  }
  v[0] += __shfl_xor(v[0], 32);
  __syncthreads();
  if (lane < 32) red[wave * 32 + lane] = v[0];
  __syncthreads();
  if (tid < 16) { float S1 = 0.f, S2 = 0.f;
#pragma unroll
    for (int w = 0; w < 8; ++w) { S1 += red[w * 32 + tid]; S2 += red[w * 32 + 16 + tid]; }
    const float mean = S1 * (1.0f / 1024.f), var = fmaxf(S2 * (1.0f / 1024.f) - mean * mean, 0.f);
    stat[2 * tid] = mean; stat[2 * tid + 1] = rsqrtf(var + EPSN); }
  __syncthreads();
  const float2 lg = *(const float2*)(p.in[21] + c0), lb = *(const float2*)(p.in[22] + c0);
#pragma unroll
  for (int t = 0; t < 16; ++t) { const float mean = stat[2 * t], rstd = stat[2 * t + 1];
    float a = (o0[t] - mean) * rstd * lg.x + lb.x, bq = (o1[t] - mean) * rstd * lg.y + lb.y; a = a * sigmf(a); bq = bq * sigmf(bq);
    *(unsigned*)(AO + (size_t)(r0 + t) * 2048 + 1024 + c0) = pk2(a, bq); }
}
__device__ __forceinline__ void ph_mix0(const Params& p, char* lds) {
  const int G = gridDim.x, bx = blockIdx.x;
#ifndef NO_CONV
  for (int it = bx; it < MTOT / 16; it += G) conv_item(p, it, lds);
#endif
  __syncthreads();
  float lam;
  { float s1 = 0.f, s2 = 0.f; for (int i = 0; i < 64; ++i) { s1 += p.in[14][i] * p.in[15][i]; s2 += p.in[16][i] * p.in[17][i]; } lam = __expf(s1) - __expf(s2) + 0.2f; }
  const bf16* Qg = (const bf16*)(p.ws + WS_Q); const bf16* Kg = (const bf16*)(p.ws + WS_K); const bf16* Vg = (const bf16*)(p.ws + WS_V); bf16* AO = (bf16*)(p.ws + WS_AO);
#ifndef NO_ATT
  for (int u = bx; u < 1024 + 64; u += G) {
    if (u < 1024) { const int bh = u >> 5, qb = u & 31, b = bh >> 3, h = bh & 7; att::attn_unit(Qg, Kg, Vg, AO, b, h, b * 4096 + qb * 128, 68, lam, p.in[18], lds); }
    else { const int c = u - 1024, b = c >> 4, h = (c >> 1) & 7, hf = c & 1; att::attn_unit(Qg, Kg, Vg, AO, b, h, MLAT + b * 256 + hf * 128, 4, lam, p.in[18], lds); }
  }
#endif
}
__device__ __forceinline__ void ph_mlconv(const Params& p) {
  const bf16* QK = (const bf16*)(p.ws + WS_QKRAW); bf16* QC = (bf16*)(p.ws + WS_QKC);
  const float* cw = p.in[24]; const float* cbias = p.in[25];
  const int stride = gridDim.x * 512;
  for (int idx = blockIdx.x * 512 + threadIdx.x; idx < MTOT * 256; idx += stride) {
    const int r = idx >> 8, c = (idx & 255) * 8;
    int s0, s1; if (r < MLAT) { s0 = r & ~4095; s1 = s0 + 4096; } else { s0 = MLAT + ((r - MLAT) & ~255); s1 = s0 + 256; }
    const u32x4 z = {0u, 0u, 0u, 0u};
    const u32x4 xm = (r - 1 >= s0) ? *(const u32x4*)(QK + (size_t)(r - 1) * 2048 + c) : z;
    const u32x4 x0 = *(const u32x4*)(QK + (size_t)r * 2048 + c);
    const u32x4 xp = (r + 1 < s1) ? *(const u32x4*)(QK + (size_t)(r + 1) * 2048 + c) : z;
    float y[8];
#pragma unroll
    for (int e = 0; e < 8; ++e) { const unsigned wm = xm[e >> 1], w0 = x0[e >> 1], wp = xp[e >> 1];
      const float a = (e & 1) ? bfhi(wm) : bflo(wm), b = (e & 1) ? bfhi(w0) : bflo(w0), d = (e & 1) ? bfhi(wp) : bflo(wp);
      float v = cbias[c + e] + cw[c + e] * a + cw[2048 + c + e] * b + cw[4096 + c + e] * d;
      v = v * sigmf(v); if (c >= 1024) v *= 0.08838834764831845f; y[e] = v; }
    u32x4 o; o.x = pk2(y[0], y[1]); o.y = pk2(y[2], y[3]); o.z = pk2(y[4], y[5]); o.w = pk2(y[6], y[7]);
    *(u32x4*)(QC + (size_t)r * 2048 + c) = o;
  }
}

namespace ml {
typedef float f4 __attribute__((ext_vector_type(4)));
typedef short s4 __attribute__((ext_vector_type(4)));
constexpr int QS = 0, KS = 17408, KT = 34816, VT = 53248, CT = 62464, NV = 79872, SC = 80384, PW = 82496;
constexpr int RS = 272, TS = 144;
#define MFMA16(a, b, c) __builtin_amdgcn_mfma_f32_16x16x32_bf16((a), (b), (c), 0, 0, 0)
__device__ __forceinline__ float wscan_add(float v, int lane) {
#pragma unroll
  for (int o = 1; o < 64; o <<= 1) { const float t = __shfl_up(v, o); if (lane >= o) v += t; }
  return v;
}
__device__ __forceinline__ float wscan_max(float v, int lane) {
#pragma unroll
  for (int o = 1; o < 64; o <<= 1) { const float t = __shfl_up(v, o); if (lane >= o) v = fmaxf(v, t); }
  return v;
}
__device__ __forceinline__ void mlstm_item(const Params& p, int item, char* lds) {
  const int tid = threadIdx.x, lane = tid & 63, w = tid >> 6, l15 = lane & 15, quad = lane >> 4;
  const int dvs = item & 3, dir = (item >> 2) & 1, h = (item >> 3) & 7, b = item >> 6;
  const bf16* QC = (const bf16*)(p.ws + WS_QKC); const bf16* V1 = (const bf16*)(p.ws + WS_V1); const float* G = (const float*)(p.ws + WS_G);
  bf16* HO = (bf16*)(p.ws + (dir ? WS_HB : WS_HF));
  const int gci = dir * 16 + h, gcf = dir * 16 + 8 + h; const float gbi = p.in[26][gci], gbf = p.in[26][gcf];
  const int lrow = tid >> 3, lc = tid & 7;
  const int ib = w & 3, ebp = w >> 2;
  float* scf = (float*)(lds + SC); float* pw = (float*)(lds + PW) + w * 64; float* nv = (float*)(lds + NV);
  f4 Cacc[4];
#pragma unroll
  for (int e = 0; e < 4; ++e) Cacc[e] = (f4){0.f, 0.f, 0.f, 0.f};
  float nreg = 0.f, mcar = 0.f;
#define ROWOF(s, i) ((s) < 4 ? (dir ? (MLAT + b * 256 + 255 - 64 * (s) - (i)) : (MLAT + b * 256 + 64 * (s) + (i))) \
                             : (dir ? (b * 4096 + 4095 - 64 * ((s) - 4) - (i)) : (b * 4096 + 64 * ((s) - 4) + (i))))
#define SCAN(s) do { const int row_ = ROWOF(s, lane); const float ig_ = G[(size_t)row_ * 32 + gci] + gbi, fr_ = G[(size_t)row_ * 32 + gcf] + gbf; \
    const float lf_ = fminf(fr_, 0.f) - log1pf(__expf(-fabsf(fr_))); const float bc_ = wscan_add(lf_, lane); const float a_ = ig_ - bc_; \
    const float A_ = fmaxf(mcar, wscan_max(a_, lane)); const float AL_ = __shfl(A_, 63), bL_ = __shfl(bc_, 63); \
    float* sb_ = scf + ((s) & 1) * 260; sb_[lane] = a_; sb_[64 + lane] = A_; sb_[128 + lane] = __expf(a_ - AL_); sb_[192 + lane] = bc_; \
    if (lane == 0) { sb_[256] = mcar; sb_[257] = __expf(mcar - AL_); } mcar = bL_ + AL_; } while (0)
  u32x4 gq0, gq1, gk0, gk1, gv;
#define GLOAD(s) do { const size_t r_ = (size_t)ROWOF(s, lrow); const bf16* qp_ = QC + r_ * 2048 + h * 128 + lc * 8; \
    gq0 = *(const u32x4*)qp_; gq1 = *(const u32x4*)(qp_ + 64); gk0 = *(const u32x4*)(qp_ + 1024); gk1 = *(const u32x4*)(qp_ + 1024 + 64); \
    gv = *(const u32x4*)(V1 + r_ * 2048 + h * 256 + dvs * 64 + lc * 8); } while (0)
  __syncthreads();
  for (int i = tid; i < 17408 / 4; i += 512) ((unsigned*)(lds + CT))[i] = 0u;
  if (tid < 128) nv[tid] = 0.f;
  if (w == 0) SCAN(0);
  GLOAD(0);
  __syncthreads();
  for (int s = 0; s < 68; ++s) {
    const float* sb = scf + (s & 1) * 260;
    { const float wj = sb[128 + lrow];
      *(u32x4*)(lds + QS + lrow * RS + lc * 16) = gq0; *(u32x4*)(lds + QS + lrow * RS + 128 + lc * 16) = gq1;
      *(u32x4*)(lds + KS + lrow * RS + lc * 16) = gk0; *(u32x4*)(lds + KS + lrow * RS + 128 + lc * 16) = gk1;
      bf16* kt = (bf16*)(lds + KT) + lrow; bf16* vt = (bf16*)(lds + VT) + lrow;
#pragma unroll
      for (int e = 0; e < 8; ++e) { const unsigned a = gk0[e >> 1], c = gk1[e >> 1], v = gv[e >> 1];
        const float ka = (e & 1) ? bfhi(a) : bflo(a), kc = (e & 1) ? bfhi(c) : bflo(c);
        kt[(lc * 8 + e) * 72] = (bf16)(pk2(ka * wj, 0.f) & 0xffffu); kt[(64 + lc * 8 + e) * 72] = (bf16)(pk2(kc * wj, 0.f) & 0xffffu);
        vt[(lc * 8 + e) * 72] = (bf16)((e & 1) ? (v >> 16) : (v & 0xffffu)); } }
    __syncthreads();
    if (s + 1 < 68) GLOAD(s + 1);
    if (w == 0 && s + 1 < 68) SCAN(s + 1);
    const float decay = sb[257];
    if (s >= 4) {
      const int iq = 16 * ib + l15;
      bf16x8 qf[4];
#pragma unroll
      for (int kk = 0; kk < 4; ++kk) qf[kk] = *(const bf16x8*)(lds + QS + iq * RS + (32 * kk + 8 * quad) * 2);
      const float Ai = sb[64 + iq], m_in = sb[256];
      f4 st[4]; float dsum = 0.f;
#pragma unroll
      for (int jb = 0; jb < 4; ++jb) { st[jb] = (f4){0.f, 0.f, 0.f, 0.f};
        if (jb <= ib) {
          f4 x = (f4){0.f, 0.f, 0.f, 0.f};
#pragma unroll
          for (int kk = 0; kk < 4; ++kk) { const bf16x8 kf = *(const bf16x8*)(lds + KS + (16 * jb + l15) * RS + (32 * kk + 8 * quad) * 2); x = MFMA16(kf, qf[kk], x); }
          const f4 aj = *(const f4*)(sb + 16 * jb + 4 * quad);
#pragma unroll
          for (int r = 0; r < 4; ++r) { const int j = 16 * jb + 4 * quad + r; const float dm = (j <= iq) ? __expf(aj[r] - Ai) : 0.f; const float sv = x[r] * dm; st[jb][r] = sv; dsum += sv; }
        } }
      float qn = 0.f;
#pragma unroll
      for (int kk = 0; kk < 4; ++kk) { const f4 n0 = *(const f4*)(nv + 32 * kk + 8 * quad), n1 = *(const f4*)(nv + 32 * kk + 8 * quad + 4);
        const u32x4 qw = __builtin_bit_cast(u32x4, qf[kk]);
        qn += bflo(qw.x) * n0[0] + bfhi(qw.x) * n0[1] + bflo(qw.y) * n0[2] + bfhi(qw.y) * n0[3] + bflo(qw.z) * n1[0] + bfhi(qw.z) * n1[1] + bflo(qw.w) * n1[2] + bfhi(qw.w) * n1[3]; }
      qn += __shfl_xor(qn, 16); qn += __shfl_xor(qn, 32); dsum += __shfl_xor(dsum, 16); dsum += __shfl_xor(dsum, 32);
      const float inter = __expf(m_in - Ai), den = inter * qn + dsum, mrow = sb[192 + iq] + Ai;
      const float rinv = 1.0f / fmaxf(fabsf(den), __expf(-mrow));
      if (quad == 0) { pw[l15] = inter; pw[16 + l15] = rinv; }
      bf16x8 sa[2];
#pragma unroll
      for (int pp = 0; pp < 2; ++pp) { u32x4 t; t.x = pk2(st[2 * pp][0], st[2 * pp][1]); t.y = pk2(st[2 * pp][2], st[2 * pp][3]); t.z = pk2(st[2 * pp + 1][0], st[2 * pp + 1][1]); t.w = pk2(st[2 * pp + 1][2], st[2 * pp + 1][3]); sa[pp] = __builtin_bit_cast(bf16x8, t); }
      asm volatile("s_waitcnt lgkmcnt(0)" ::: "memory");
      const f4 in4 = *(const f4*)(pw + 4 * quad), ri4 = *(const f4*)(pw + 16 + 4 * quad);
#pragma unroll
      for (int e2 = 0; e2 < 2; ++e2) { const int eb = 2 * ebp + e2, ecol = 16 * eb + l15;
        f4 qc = (f4){0.f, 0.f, 0.f, 0.f}, sv = (f4){0.f, 0.f, 0.f, 0.f};
#pragma unroll
        for (int kk = 0; kk < 4; ++kk) { const bf16x8 cf = *(const bf16x8*)(lds + CT + ecol * RS + (32 * kk + 8 * quad) * 2); qc = MFMA16(qf[kk], cf, qc); }
#pragma unroll
        for (int pp = 0; pp < 2; ++pp) if (2 * pp <= ib) { const s4 v0 = *(const s4*)(lds + VT + ecol * TS + (32 * pp + 4 * quad) * 2), v1 = *(const s4*)(lds + VT + ecol * TS + (32 * pp + 16 + 4 * quad) * 2);
          const bf16x8 vf = (bf16x8){v0[0], v0[1], v0[2], v0[3], v1[0], v1[1], v1[2], v1[3]}; sv = MFMA16(sa[pp], vf, sv); }
#pragma unroll
        for (int r = 0; r < 4; ++r) { const float hv = (in4[r] * qc[r] + sv[r]) * ri4[r]; const int row = ROWOF(s, 16 * ib + 4 * quad + r);
          HO[(size_t)row * 2048 + h * 256 + dvs * 64 + ecol] = (bf16)(pk2(hv, 0.f) & 0xffffu); } }
    }
    { bf16x8 af[2];
#pragma unroll
      for (int sk = 0; sk < 2; ++sk) af[sk] = *(const bf16x8*)(lds + KT + (16 * w + l15) * TS + (32 * sk + 8 * quad) * 2);
#pragma unroll
      for (int eb = 0; eb < 4; ++eb) { Cacc[eb] = Cacc[eb] * decay;
#pragma unroll
        for (int sk = 0; sk < 2; ++sk) { const bf16x8 vf = *(const bf16x8*)(lds + VT + (16 * eb + l15) * TS + (32 * sk + 8 * quad) * 2); Cacc[eb] = MFMA16(af[sk], vf, Cacc[eb]); } } }
    if (tid < 128) { float acc = 0.f;
#pragma unroll
      for (int q8 = 0; q8 < 8; ++q8) { const u32x4 kw = *(const u32x4*)(lds + KT + tid * TS + q8 * 16);
        acc += (bflo(kw.x) + bfhi(kw.x)) + (bflo(kw.y) + bfhi(kw.y)) + (bflo(kw.z) + bfhi(kw.z)) + (bflo(kw.w) + bfhi(kw.w)); }
      nreg = decay * nreg + acc; }
    __syncthreads();
#pragma unroll
    for (int eb = 0; eb < 4; ++eb) { u32x2 t; t.x = pk2(Cacc[eb][0], Cacc[eb][1]); t.y = pk2(Cacc[eb][2], Cacc[eb][3]); *(u32x2*)(lds + CT + (16 * eb + l15) * RS + (16 * w + 4 * quad) * 2) = t; }
    if (tid < 128) nv[tid] = nreg;
  }
#undef ROWOF
#undef SCAN
#undef GLOAD
}
#undef MFMA16
}
__device__ __forceinline__ void ph_mlstm(const Params& p, char* lds) { for (int it = blockIdx.x; it < 256; it += gridDim.x) ml::mlstm_item(p, it, lds); }

__device__ __forceinline__ void ph_mlcomb(const Params& p) {
  const int lane = threadIdx.x & 63, wave = threadIdx.x >> 6, gw = blockIdx.x * 8 + wave, NGW = gridDim.x * 8;
  const bf16* HF = (const bf16*)(p.ws + WS_HF); const bf16* HB = (const bf16*)(p.ws + WS_HB); const bf16* O1 = (const bf16*)(p.ws + WS_O1); bf16* AO = (bf16*)(p.ws + WS_AO1);
  for (int r = gw; r < MLAT; r += NGW) {
    const size_t off = (size_t)r * 2048 + 32 * lane; float v[32]; float ss = 0.f;
#pragma unroll
    for (int q = 0; q < 4; ++q) { const u32x4 a = *(const u32x4*)(HF + off + 8 * q), bq = *(const u32x4*)(HB + off + 8 * q);
#pragma unroll
      for (int e = 0; e < 4; ++e) { const float x0 = bflo(a[e]) + bflo(bq[e]), x1 = bfhi(a[e]) + bfhi(bq[e]); v[8 * q + 2 * e] = x0; v[8 * q + 2 * e + 1] = x1; ss += x0 * x0 + x1 * x1; } }
    ss += __shfl_xor(ss, 1); ss += __shfl_xor(ss, 2); ss += __shfl_xor(ss, 4);
    const float rs = rsqrtf(ss * (1.0f / 256.f) + EPSN);
    const float* ng = p.in[27] + 32 * lane;
#pragma unroll
    for (int q = 0; q < 4; ++q) { const u32x4 og = *(const u32x4*)(O1 + off + 8 * q); u32x4 o;
#pragma unroll
      for (int e = 0; e < 4; ++e) { const float y0 = v[8 * q + 2 * e] * rs * ng[8 * q + 2 * e] * sigmf(bflo(og[e])), y1 = v[8 * q + 2 * e + 1] * rs * ng[8 * q + 2 * e + 1] * sigmf(bfhi(og[e])); o[e] = pk2(y0, y1); }
      *(u32x4*)(AO + off + 8 * q) = o; }
  }
}
constexpr int NPHASE = 18;
#ifndef ONLY_PH
#define ONLY_PH -1
#endif
#define EN(k) (ONLY_PH < 0 || ONLY_PH == (k))
__global__ void __launch_bounds__(512, 2) mega_fwd(Params p) {
  extern __shared__ __attribute__((aligned(16))) unsigned char lds[];
  cg::grid_group grid = cg::this_grid();
  PG8_LAS unsigned char* l3 = (PG8_LAS unsigned char*)lds;
  unsigned char* ws = p.ws;
  const int lo = p.ph_lo, hi = p.ph_hi;
#define IN(k) (EN(k) && lo <= (k) && (k) < hi)
#define SEAM(k) do { if (lo <= (k) && (k) + 1 < hi) grid.sync(); } while (0)
  if (IN(0)) { ph_prologue(p, (LAS unsigned char*)lds); }
  SEAM(0);
  if (IN(1)) { ph_rows(p, MTOT, true, false, 0, 0, nullptr, true, 0, 0, p.in[6]); }
  SEAM(1);
  if (IN(2)) { { pg8::Gemm g{(const pg8::bf16_t*)(ws + WS_H), (const pg8::bf16_t*)(ws + WS_HYIN), MTOT, 5120, 2048}; pg8::StaticOrder S; S.init(MTOT, 5120, gridDim.x, blockIdx.x);
                pg8::EpiHyIn E{(pg8::bf16_t*)(ws + WS_Q), (pg8::bf16_t*)(ws + WS_V), (pg8::bf16_t*)(ws + WS_UG), (size_t)(WS_K - WS_Q) / 2, (const float*)(ws + WS_ROPE)};
                pg8::gemm_phase<pg8::EpiHyIn, pg8::StaticOrder, true, true>(l3, g, S, E); } }
  SEAM(2);
  if (IN(3)) { ph_mix0(p, (char*)lds); }
  SEAM(3);
  if (IN(4)) { { pg8::Gemm g{(const pg8::bf16_t*)(ws + WS_AO), (const pg8::bf16_t*)(ws + WS_HYOUT), MTOT, 2048, 2048}; pg8::StaticOrder S; S.init(MTOT, 2048, gridDim.x, blockIdx.x);
                pg8::EpiF32 E{(float*)(ws + WS_Y), 2048}; pg8::gemm_phase<pg8::EpiF32, pg8::StaticOrder, true, true>(l3, g, S, E); } }
  SEAM(4);
  if (IN(5)) { ph_rows(p, MTOT, true, true, 0, 2, p.in[7], true, 0, 3, p.in[8]); }
  SEAM(5);
  if (IN(6)) { { pg8::Gemm g{(const pg8::bf16_t*)(ws + WS_H), (const pg8::bf16_t*)(ws + WS_FFN1_0), MTOT, 8192, 2048}; pg8::StaticOrder S; S.init(MTOT, 8192, gridDim.x, blockIdx.x);
                pg8::EpiRelu2 E{(pg8::bf16_t*)(ws + WS_HFF), 8192}; pg8::gemm_phase<pg8::EpiRelu2, pg8::StaticOrder, true, true>(l3, g, S, E); } }
  SEAM(6);
  if (IN(7)) { { pg8::Gemm g{(const pg8::bf16_t*)(ws + WS_HFF), (const pg8::bf16_t*)(ws + WS_FFN2_0), MTOT, 2048, 8192}; pg8::StaticOrder S; S.init(MTOT, 2048, gridDim.x, blockIdx.x);
                pg8::EpiF32 E{(float*)(ws + WS_Y), 2048}; pg8::gemm_phase<pg8::EpiF32, pg8::StaticOrder, true, true>(l3, g, S, E); } }
  SEAM(7);
  if (IN(8)) { ph_rows(p, MTOT, false, true, 0, 5, p.in[9], true, 1, 0, p.in[6] + 2048); }
  SEAM(8);
  if (IN(9)) { { pg8::Gemm g{(const pg8::bf16_t*)(ws + WS_H), (const pg8::bf16_t*)(ws + WS_MLIN), MTOT, 6400, 2048}; pg8::StaticOrder S; S.init(MTOT, 6400, gridDim.x, blockIdx.x);
                pg8::EpiMlIn E{(pg8::bf16_t*)(ws + WS_QKRAW), (size_t)(WS_V1 - WS_QKRAW) / 2, (float*)(ws + WS_G)};
                pg8::gemm_phase<pg8::EpiMlIn, pg8::StaticOrder, true, true>(l3, g, S, E); } }
  SEAM(9);
  if (IN(10)) { ph_mlconv(p); }
  SEAM(10);
  if (IN(11)) { ph_mlstm(p, (char*)lds); }
  SEAM(11);
  if (IN(12)) { ph_mlcomb(p); }
  SEAM(12);
  if (IN(13)) { { pg8::Gemm g{(const pg8::bf16_t*)(ws + WS_AO1), (const pg8::bf16_t*)(ws + WS_MLOUT), MLAT, 2048, 2048}; pg8::StaticOrder S; S.init(MLAT, 2048, gridDim.x, blockIdx.x);
                 pg8::EpiF32 E{(float*)(ws + WS_Y), 2048}; pg8::gemm_phase<pg8::EpiF32, pg8::StaticOrder, true, true>(l3, g, S, E); } }
  SEAM(13);
  if (IN(14)) { ph_rows(p, MLAT, false, true, 1, 2, p.in[7] + 2048, true, 1, 3, p.in[8] + 2048); }
  SEAM(14);
  if (IN(15)) { { pg8::Gemm g{(const pg8::bf16_t*)(ws + WS_H), (const pg8::bf16_t*)(ws + WS_FFN1_1), MLAT, 8192, 2048}; pg8::StaticOrder S; S.init(MLAT, 8192, gridDim.x, blockIdx.x);
                 pg8::EpiRelu2 E{(pg8::bf16_t*)(ws + WS_HFF), 8192}; pg8::gemm_phase<pg8::EpiRelu2, pg8::StaticOrder, true, true>(l3, g, S, E); } }
  SEAM(15);
  if (IN(16)) { { pg8::Gemm g{(const pg8::bf16_t*)(ws + WS_HFF), (const pg8::bf16_t*)(ws + WS_FFN2_1), MLAT, 2048, 8192}; pg8::StaticOrder S; S.init(MLAT, 2048, gridDim.x, blockIdx.x);
                 pg8::EpiF32 E{(float*)(ws + WS_Y), 2048}; pg8::gemm_phase<pg8::EpiF32, pg8::StaticOrder, true, true>(l3, g, S, E); } }
  SEAM(16);
  if (IN(17)) { ph_rows(p, MLAT, false, true, 1, 5, p.in[9] + 2048, false, 0, 0, nullptr); }
  SEAM(17);
#undef IN
#undef SEAM
}

#ifndef MK_SPLIT
#define MK_SPLIT 0
#endif
extern "C" void kernel_launch(void* const* d_in, const int* in_sizes, int n_in, void* d_out, int out_size, void* d_ws, size_t ws_size, hipStream_t stream) {
  static int grid = 0;
  if (grid == 0) {
    if (n_in != 29 || out_size != MLAT * DM || ws_size < WS_END) { fprintf(stderr, "kernel_launch: unexpected shapes (n_in %d out %d ws %zu need %zu)\n", n_in, out_size, ws_size, (size_t)WS_END); grid = -1; return; }
    int dev = 0, cus = 0, per_cu = 0;
    hipGetDevice(&dev); hipDeviceGetAttribute(&cus, hipDeviceAttributeMultiprocessorCount, dev);
    hipFuncSetAttribute((const void*)mega_fwd, hipFuncAttributeMaxDynamicSharedMemorySize, LDS_BYTES);
    hipOccupancyMaxActiveBlocksPerMultiprocessor(&per_cu, (const void*)mega_fwd, 512, LDS_BYTES);
    if (per_cu < 1) per_cu = 1;
    (void)hipGetLastError();
    grid = cus * 1;
  }
  if (grid < 0) return;
  hipMemsetAsync((char*)d_ws + WS_MOD, 0, 2 * MODSZ * sizeof(float), stream);
  Params p{};
  for (int i = 0; i < 29; ++i) p.in[i] = (const float*)d_in[i];
  p.out = (float*)d_out; p.ws = (unsigned char*)d_ws;
#if MK_SPLIT
  for (int ph = 0; ph < NPHASE; ++ph) { p.ph_lo = ph; p.ph_hi = ph + 1; hipLaunchKernelGGL(mega_fwd, dim3(grid), dim3(512), LDS_BYTES, stream, p); }
#else
  p.ph_lo = 0; p.ph_hi = NPHASE;
  void* args[] = {&p};
  hipError_t e = hipLaunchCooperativeKernel((const void*)mega_fwd, dim3(grid), dim3(512), args, LDS_BYTES, stream);
  if (e != hipSuccess) fprintf(stderr, "cooperative launch failed: %s (grid %d)\n", hipGetErrorString(e), grid);
#endif
}
```

```cpp
#include <hip/hip_runtime.h>
#include <hip/hip_cooperative_groups.h>
#include <cstdio>
#include <cstdint>
namespace cg = cooperative_groups;
namespace pg8 {
#define PG8_LAS __attribute__((address_space(3)))
typedef unsigned short bf16_t;
typedef short bf16x8 __attribute__((ext_vector_type(8)));
typedef float f32x4 __attribute__((ext_vector_type(4)));
typedef unsigned u32x4 __attribute__((ext_vector_type(4)));
constexpr int BM = 256, BK = 64, HALF = 128, HTB = HALF * BK * 2  , STAGE_BYTES = 8 * HTB, NXCD = 8, WGM = 8;

__host__ __device__ __forceinline__ int lds_byte(int r, int c) { const int st = (r >> 4) * 2 + (c >> 5), rr = r & 15, cc = c & 31, ob = rr * 64 + cc * 2; return st * 1024 + (ob ^ (((ob >> 9) & 1) << 5)); }
__host__ __device__ __forceinline__ void stage_rc(int b, int& R, int& C) { const int st = b / 1024, sb = b % 1024, swz = sb ^ (((sb >> 9) & 1) << 5); R = (st >> 1) * 16 + swz / 64; C = (st & 1) * 32 + (swz % 64) / 2; }
__host__ __device__ __forceinline__ int perm32(int rho) { const int n = rho >> 4, i = rho & 15; return 8 * (i >> 2) + 4 * n + (i & 3); }

struct Unit { int pm, pn, kofs, ks; };
struct Gemm { const bf16_t* A; const bf16_t* Bt; int M, N, K, ld; };

struct StaticOrder {
    int nM, nN, nwg, G, c;
    __host__ __device__ void init(int M, int N, int G_, int c_) { nM = M / BM; nN = N / BM; nwg = nM * nN; G = G_; c = c_; }
    __host__ __device__ bool next(int i, Unit& u) const {
        const long L = (long)i * G + c; if (L >= nwg) return false;
        int wgid = (int)L; { const int q = nwg / NXCD, r = nwg % NXCD, xcd = wgid % NXCD, off = wgid / NXCD; wgid = (xcd < r ? xcd * (q + 1) : r * (q + 1) + (xcd - r) * q) + off; }
        const int nig = WGM * nN, gid = wgid / nig, fm = gid * WGM, gsz = (nM - fm) < WGM ? (nM - fm) : WGM;
        u.pm = fm + ((wgid % nig) % gsz); u.pn = (wgid % nig) / gsz; u.kofs = 0; u.ks = 0; return true;
    }
    __device__ __forceinline__ void a_ready(const Unit&) const {}
    __device__ __forceinline__ void done(const Unit&) const {}
};

struct SplitOrder {
    int nN, nu, G, c, kslice;
    __host__ __device__ void init(int N, int kslice_, int G_, int c_) { nN = N / BM; nu = 4 * nN * 8; G = G_; c = c_; kslice = kslice_; }
    __host__ __device__ bool next(int i, Unit& u) const {
        const long L = (long)i * G + c; if (L >= nu) return false;
        const int per = 4 * nN, ks = (int)L / per, rem = (int)L % per; u.pn = rem >> 2; u.pm = 64 + (rem & 3); u.ks = ks; u.kofs = ks * kslice; return true;
    }
    __device__ __forceinline__ void a_ready(const Unit&) const {}
    __device__ __forceinline__ void done(const Unit&) const {}
};
__device__ __forceinline__ unsigned cvt_pk_bf16(float lo, float hi) { unsigned r; asm volatile("v_cvt_pk_bf16_f32 %0, %1, %2" : "=v"(r) : "v"(lo), "v"(hi)); return r; }
typedef float f32x2 __attribute__((ext_vector_type(2)));
template <class Epi, class Sched, bool ALIGN_EPI = false, bool SP2 = false>
__device__ __forceinline__ void gemm_phase(PG8_LAS unsigned char* lds, const Gemm g, const Sched& S, const Epi& E) {
    const int tid = threadIdx.x, wid = __builtin_amdgcn_readfirstlane(tid >> 6), lane = tid & 63, wr = wid >> 2, wc = wid & 3, fr = lane & 15, fq = lane >> 4;
    const int K = g.K, nt = K / BK, ld = g.ld;
    unsigned voffA[2], voffB[2];
#pragma unroll
    for (int i = 0; i < 2; ++i) { int R, C; stage_rc(tid * 16 + i * 8192, R, C); const int Rb = Epi::PERM ? ((R & ~31) + perm32(R & 31)) : R;
        voffA[i] = (unsigned)(R * ld + C) * 2u; voffB[i] = (unsigned)(Rb * ld + C) * 2u; }
    const size_t kstep = (size_t)(BK * 2);
    const size_t hstep = (size_t)HALF * ld * 2;
    const size_t tstep = 2 * hstep;
    const unsigned ldsw = (unsigned)wid * 1024u;
    const int aoff = lds_byte(wr * 64 + fr, fq * 8), boff = lds_byte(wc * 32 + fr, fq * 8);
#define PG8_SA(b, h) (((b) * 2 + (h)) * HTB)
#define PG8_SB(b, h) ((4 + (b) * 2 + (h)) * HTB)
#define PG8_STAGE(bufoff, gbase, voff) do { _Pragma("unroll") for (int _i = 0; _i < 2; ++_i) \
        __builtin_amdgcn_global_load_lds((const unsigned*)((const char*)(gbase) + (voff)[_i]), (PG8_LAS unsigned*)(lds + (bufoff) + ldsw + _i * 8192), 16, 0, 0); } while (0)
#define PG8_LDA(dst, b, h) do { _Pragma("unroll") for (int m = 0; m < 4; ++m) _Pragma("unroll") for (int k = 0; k < 2; ++k) dst[m][k] = *(const PG8_LAS bf16x8*)(lds + PG8_SA(b, h) + aoff + m * 2048 + k * 1024); } while (0)
#define PG8_LDB(dst, b, h) do { _Pragma("unroll") for (int n = 0; n < 2; ++n) _Pragma("unroll") for (int k = 0; k < 2; ++k) dst[n][k] = *(const PG8_LAS bf16x8*)(lds + PG8_SB(b, h) + boff + n * 2048 + k * 1024); } while (0)
#define PG8_MMA(ai, bj, At, Bt) do { __builtin_amdgcn_s_setprio(1); _Pragma("unroll") for (int m = 0; m < 4; ++m) _Pragma("unroll") for (int n = 0; n < 2; ++n) _Pragma("unroll") for (int k = 0; k < 2; ++k) \
        acc[ai][bj][m][n] = __builtin_amdgcn_mfma_f32_16x16x32_bf16(Bt[n][k], At[m][k], acc[ai][bj][m][n], 0, 0, 0); __builtin_amdgcn_s_setprio(0); } while (0)
#define PG8_WAIT_V(n) asm volatile("s_waitcnt vmcnt(" #n ")" ::: "memory")
#define PG8_WAIT_L(n) asm volatile("s_waitcnt lgkmcnt(" #n ")" ::: "memory")
#define PG8_BAR __builtin_amdgcn_s_barrier()
#define PG8_SCHED __builtin_amdgcn_sched_barrier(0)
    Unit cur, nxt; int ui = 0;
    if (!S.next(0, cur)) return;
    f32x4 acc[2][2][4][2];
#pragma unroll
    for (int a = 0; a < 2; ++a)
#pragma unroll
        for (int b = 0; b < 2; ++b)
#pragma unroll
            for (int m = 0; m < 4; ++m)
#pragma unroll
                for (int n = 0; n < 2; ++n) acc[a][b][m][n] = (f32x4){0.f, 0.f, 0.f, 0.f};
    bf16x8 At[4][2], B0[2][2], B1[2][2];
    const char* cA = (const char*)g.A + (size_t)cur.pm * tstep + (size_t)cur.kofs * 2; const char* cB = (const char*)g.Bt + (size_t)cur.pn * tstep + (size_t)cur.kofs * 2;
    S.a_ready(cur);
    if constexpr (SP2) {
        PG8_STAGE(PG8_SB(0, 0), cB, voffB); PG8_STAGE(PG8_SB(0, 1), cB + hstep, voffB); PG8_STAGE(PG8_SA(0, 0), cA, voffA); PG8_STAGE(PG8_SA(0, 1), cA + hstep, voffA);
        if (wr == 1) PG8_BAR;
        PG8_WAIT_V(2); PG8_BAR;
        PG8_STAGE(PG8_SB(1, 0), cB + kstep, voffB); PG8_STAGE(PG8_SA(1, 0), cA + kstep, voffA); PG8_STAGE(PG8_SB(1, 1), cB + hstep + kstep, voffB);
        PG8_WAIT_V(6); PG8_BAR;
    } else {
        PG8_STAGE(PG8_SB(0, 0), cB, voffB); PG8_STAGE(PG8_SA(0, 0), cA, voffA); PG8_STAGE(PG8_SB(0, 1), cB + hstep, voffB); PG8_STAGE(PG8_SA(0, 1), cA + hstep, voffA);
        if (wr == 1) PG8_BAR;
        PG8_WAIT_V(4); PG8_BAR;
        PG8_STAGE(PG8_SB(1, 0), cB + kstep, voffB); PG8_STAGE(PG8_SA(1, 0), cA + kstep, voffA); PG8_STAGE(PG8_SB(1, 1), cB + hstep + kstep, voffB);
        PG8_WAIT_V(6); PG8_BAR;
    }
    for (;;) {
        const bool has_next = S.next(ui + 1, nxt);
        const char* nA = has_next ? (const char*)g.A + (size_t)nxt.pm * tstep + (size_t)nxt.kofs * 2 : cA; const char* nB = has_next ? (const char*)g.Bt + (size_t)nxt.pn * tstep + (size_t)nxt.kofs * 2 : cB;
        for (int t = 0; t < nt; t += 2) {
            const bool last = (t == nt - 2);
            const char* a1 = cA + (size_t)(t + 1) * kstep;
            const char* a2 = last ? nA : cA + (size_t)(t + 2) * kstep; const char* b2 = last ? nB : cB + (size_t)(t + 2) * kstep;
            const char* a3 = a2 + kstep; const char* b3 = b2 + kstep;
            if (last && has_next) S.a_ready(nxt);
            if constexpr (SP2) {
            PG8_LDB(B0, 0, 0); PG8_LDB(B1, 0, 1); PG8_SCHED; PG8_LDA(At, 0, 0); PG8_STAGE(PG8_SA(1, 1), a1 + hstep, voffA);
            PG8_WAIT_V(8); PG8_WAIT_L(0); PG8_BAR; PG8_MMA(0, 0, At, B0); PG8_MMA(0, 1, At, B1); PG8_BAR; PG8_SCHED;
            PG8_LDA(At, 0, 1); PG8_STAGE(PG8_SB(0, 0), b2, voffB); PG8_STAGE(PG8_SB(0, 1), b2 + hstep, voffB); PG8_STAGE(PG8_SA(0, 0), a2, voffA);
            PG8_WAIT_V(8); PG8_WAIT_L(0); PG8_BAR; PG8_MMA(1, 0, At, B0); PG8_MMA(1, 1, At, B1); PG8_BAR; PG8_SCHED;
            PG8_LDB(B0, 1, 0); PG8_LDB(B1, 1, 1); PG8_SCHED; PG8_LDA(At, 1, 0); PG8_STAGE(PG8_SA(0, 1), a2 + hstep, voffA);
            PG8_WAIT_V(8); PG8_WAIT_L(0); PG8_BAR; PG8_MMA(0, 0, At, B0); PG8_MMA(0, 1, At, B1); PG8_BAR; PG8_SCHED;
            PG8_LDA(At, 1, 1); PG8_STAGE(PG8_SB(1, 0), b3, voffB); PG8_STAGE(PG8_SB(1, 1), b3 + hstep, voffB); PG8_STAGE(PG8_SA(1, 0), a3, voffA);
            PG8_WAIT_V(8); PG8_WAIT_L(0); PG8_BAR; PG8_MMA(1, 0, At, B0); PG8_MMA(1, 1, At, B1); PG8_BAR; PG8_SCHED;
            } else {
            PG8_LDB(B0, 0, 0); PG8_SCHED; PG8_LDA(At, 0, 0); PG8_STAGE(PG8_SA(1, 1), a1 + hstep, voffA);
            PG8_WAIT_L(8); PG8_BAR; PG8_WAIT_L(0); PG8_MMA(0, 0, At, B0); PG8_BAR; PG8_SCHED;
            PG8_LDB(B1, 0, 1); PG8_STAGE(PG8_SB(0, 0), b2, voffB);
            PG8_BAR; PG8_WAIT_L(0); PG8_MMA(0, 1, At, B1); PG8_BAR;
            PG8_LDA(At, 0, 1); PG8_STAGE(PG8_SA(0, 0), a2, voffA);
            PG8_BAR; PG8_WAIT_L(0); PG8_MMA(1, 0, At, B0); PG8_BAR; PG8_SCHED;
            PG8_STAGE(PG8_SB(0, 1), b2 + hstep, voffB);
            PG8_WAIT_V(6); PG8_BAR; PG8_MMA(1, 1, At, B1); PG8_BAR;
            PG8_LDB(B0, 1, 0); PG8_SCHED; PG8_LDA(At, 1, 0); PG8_STAGE(PG8_SA(0, 1), a2 + hstep, voffA);
            PG8_WAIT_L(8); PG8_BAR; PG8_WAIT_L(0); PG8_MMA(0, 0, At, B0); PG8_BAR; PG8_SCHED;
            PG8_LDB(B1, 1, 1); PG8_STAGE(PG8_SB(1, 0), b3, voffB);
            PG8_BAR; PG8_WAIT_L(0); PG8_MMA(0, 1, At, B1); PG8_BAR;
            PG8_LDA(At, 1, 1); PG8_STAGE(PG8_SA(1, 0), a3, voffA);
            PG8_BAR; PG8_WAIT_L(0); PG8_MMA(1, 0, At, B0); PG8_BAR; PG8_SCHED;
            PG8_STAGE(PG8_SB(1, 1), b3 + hstep, voffB);
            PG8_WAIT_V(6); PG8_BAR; PG8_MMA(1, 1, At, B1); PG8_BAR;
            }
        }
        if constexpr (ALIGN_EPI) { if (wr == 0) PG8_BAR; }
        if constexpr (!Epi::AFTER_DRAIN) { E(acc, cur, wr, wc, fr, fq); S.done(cur); }
        if (!has_next) break;
#pragma unroll
        for (int a = 0; a < 2; ++a)
#pragma unroll
            for (int b = 0; b < 2; ++b)
#pragma unroll
                for (int m = 0; m < 4; ++m)
#pragma unroll
                    for (int n = 0; n < 2; ++n) acc[a][b][m][n] = (f32x4){0.f, 0.f, 0.f, 0.f};
        cur = nxt; cA = nA; cB = nB; ++ui;
        if constexpr (ALIGN_EPI) { if (wr == 1) PG8_BAR; }
    }
    PG8_WAIT_V(0);
    if constexpr (!ALIGN_EPI) { if (wr == 0) PG8_BAR; }
    PG8_BAR;
    if constexpr (Epi::AFTER_DRAIN) { E.fused(acc, cur, wr, wc, fr, fq, lds, wid, lane); S.done(cur); }
#undef PG8_SA
#undef PG8_SB
#undef PG8_STAGE
#undef PG8_LDA
#undef PG8_LDB
#undef PG8_MMA
#undef PG8_WAIT_V
#undef PG8_WAIT_L
#undef PG8_BAR
#undef PG8_SCHED
}
typedef unsigned u32x2 __attribute__((ext_vector_type(2)));
__device__ __forceinline__ unsigned pkbf(float lo, float hi) { typedef float f2 __attribute__((ext_vector_type(2))); typedef __bf16 b2 __attribute__((ext_vector_type(2))); f2 v = {lo, hi}; b2 b = __builtin_convertvector(v, b2); return __builtin_bit_cast(unsigned, b); }
__device__ __forceinline__ u32x4 pk8(const f32x4 v0, const f32x4 v1) { u32x4 w; w.x = pkbf(v0[0], v0[1]); w.y = pkbf(v0[2], v0[3]); w.z = pkbf(v1[0], v1[1]); w.w = pkbf(v1[2], v1[3]); return w; }
__device__ __forceinline__ float sigm(float x) { return 1.0f / (1.0f + __expf(-x)); }
struct EpiF32 {
    static constexpr bool PERM = false, AFTER_DRAIN = false;
    float* O; int ldc; size_t kstride;
    __device__ __forceinline__ void operator()(const f32x4 (&acc)[2][2][4][2], const Unit& u, int wr, int wc, int fr, int fq) const {
        const int row0 = u.pm * BM + wr * 64 + fr, col0 = u.pn * BM + wc * 32 + 4 * fq; float* Ob = O + (size_t)u.ks * kstride;
#pragma unroll
        for (int ai = 0; ai < 2; ++ai)
#pragma unroll
            for (int m = 0; m < 4; ++m) { float* rowp = Ob + (size_t)(row0 + ai * HALF + m * 16) * ldc + col0;
#pragma unroll
                for (int bj = 0; bj < 2; ++bj)
#pragma unroll
                    for (int n = 0; n < 2; ++n) *(f32x4*)(rowp + bj * HALF + n * 16) = acc[ai][bj][m][n]; }
    }
};
struct EpiY16 {
    static constexpr bool PERM = true, AFTER_DRAIN = false;
    bf16_t* O; int ldc;
    __device__ __forceinline__ void operator()(const f32x4 (&acc)[2][2][4][2], const Unit& u, int wr, int wc, int fr, int fq) const {
        const int row0 = u.pm * BM + wr * 64 + fr, col0 = u.pn * BM + wc * 32 + 8 * fq;
#pragma unroll
        for (int ai = 0; ai < 2; ++ai)
#pragma unroll
            for (int m = 0; m < 4; ++m) { bf16_t* rowp = O + (size_t)(row0 + ai * HALF + m * 16) * ldc + col0;
#pragma unroll
                for (int bj = 0; bj < 2; ++bj) *(u32x4*)(rowp + bj * HALF) = pk8(acc[ai][bj][m][0], acc[ai][bj][m][1]); }
    }
};
struct EpiRelu2 {
    static constexpr bool PERM = true, AFTER_DRAIN = false;
    bf16_t* O; int ldc;
    __device__ __forceinline__ void operator()(const f32x4 (&acc)[2][2][4][2], const Unit& u, int wr, int wc, int fr, int fq) const {
        const int row0 = u.pm * BM + wr * 64 + fr, col0 = u.pn * BM + wc * 32 + 8 * fq;
#pragma unroll
        for (int ai = 0; ai < 2; ++ai)
#pragma unroll
            for (int m = 0; m < 4; ++m) { bf16_t* rowp = O + (size_t)(row0 + ai * HALF + m * 16) * ldc + col0;
#pragma unroll
                for (int bj = 0; bj < 2; ++bj) { f32x4 v0 = acc[ai][bj][m][0], v1 = acc[ai][bj][m][1];
#pragma unroll
                    for (int e = 0; e < 4; ++e) { const float a = __builtin_amdgcn_fmed3f(v0[e], 0.f, 3.0e38f), b = __builtin_amdgcn_fmed3f(v1[e], 0.f, 3.0e38f); v0[e] = a * a; v1[e] = b * b; }
                    *(u32x4*)(rowp + bj * HALF) = pk8(v0, v1); } }
    }
};
struct EpiHyIn {
    static constexpr bool PERM = true, AFTER_DRAIN = false;
    bf16_t *Qb, *Vb, *UG; size_t sec; const PG8_LAS float* rope;
    __device__ __forceinline__ void operator()(const f32x4 (&acc)[2][2][4][2], const Unit& u, int wr, int wc, int fr, int fq) const {
        const int pn = u.pn, row0 = u.pm * BM + wr * 64 + fr, cbase = wc * 32 + 8 * fq;
        if (pn < 8) {
            bf16_t* base = Qb + (size_t)(pn >> 2) * sec + (pn & 3) * 256 + cbase; const bool rope_on = u.pm < 64;
#pragma unroll
            for (int ai = 0; ai < 2; ++ai)
#pragma unroll
                for (int m = 0; m < 4; ++m) { const int row = row0 + ai * HALF + m * 16;
                    f32x4 cs0 = {1.f, 0.f, 1.f, 0.f}, cs1 = {1.f, 0.f, 1.f, 0.f};
                    if (rope_on) { const int t = row & 4095, pos = (wc & 1) ? (t & 63) : (t >> 6); const PG8_LAS f32x4* tp = (const PG8_LAS f32x4*)(rope + (pos * 16 + 4 * fq) * 2); cs0 = tp[0]; cs1 = tp[1]; }
#pragma unroll
                    for (int bj = 0; bj < 2; ++bj) { const f32x4 v0 = acc[ai][bj][m][0], v1 = acc[ai][bj][m][1]; f32x4 o0, o1;
                        o0[0] = v0[0] * cs0[0] - v0[1] * cs0[1]; o0[1] = v0[1] * cs0[0] + v0[0] * cs0[1];
                        o0[2] = v0[2] * cs0[2] - v0[3] * cs0[3]; o0[3] = v0[3] * cs0[2] + v0[2] * cs0[3];
                        o1[0] = v1[0] * cs1[0] - v1[1] * cs1[1]; o1[1] = v1[1] * cs1[0] + v1[0] * cs1[1];
                        o1[2] = v1[2] * cs1[2] - v1[3] * cs1[3]; o1[3] = v1[3] * cs1[2] + v1[2] * cs1[3];
                        *(u32x4*)(base + (size_t)row * 1024 + bj * HALF) = pk8(o0, o1); } }
        } else if (pn < 12) {
            bf16_t* base = Vb + (pn - 8) * 256 + cbase;
#pragma unroll
            for (int ai = 0; ai < 2; ++ai)
#pragma unroll
                for (int m = 0; m < 4; ++m) { const int row = row0 + ai * HALF + m * 16;
#pragma unroll
                    for (int bj = 0; bj < 2; ++bj) *(u32x4*)(base + (size_t)row * 1024 + bj * HALF) = pk8(acc[ai][bj][m][0], acc[ai][bj][m][1]); }
        } else {
            bf16_t* base = UG + ((pn - 12) * 256 + cbase) / 2;
#pragma unroll
            for (int ai = 0; ai < 2; ++ai)
#pragma unroll
                for (int m = 0; m < 4; ++m) { const int row = row0 + ai * HALF + m * 16;
#pragma unroll
                    for (int bj = 0; bj < 2; ++bj) { const f32x4 v0 = acc[ai][bj][m][0], v1 = acc[ai][bj][m][1];
                        u32x2 w; w.x = pkbf(v0[0] * sigm(v0[1]), v0[2] * sigm(v0[3])); w.y = pkbf(v1[0] * sigm(v1[1]), v1[2] * sigm(v1[3]));
                        *(u32x2*)(base + (size_t)row * 1024 + bj * 64) = w; } }
        }
    }
};
struct EpiMlIn {
    static constexpr bool PERM = true, AFTER_DRAIN = false;
    bf16_t* QK; size_t sec; float* G;
    __device__ __forceinline__ void operator()(const f32x4 (&acc)[2][2][4][2], const Unit& u, int wr, int wc, int fr, int fq) const {
        const int pn = u.pn, row0 = u.pm * BM + wr * 64 + fr, cbase = wc * 32 + 8 * fq;
        if (pn < 24) {
            bf16_t* base = QK + (size_t)(pn >> 3) * sec + (pn & 7) * 256 + cbase;
#pragma unroll
            for (int ai = 0; ai < 2; ++ai)
#pragma unroll
                for (int m = 0; m < 4; ++m) { const int row = row0 + ai * HALF + m * 16;
#pragma unroll
                    for (int bj = 0; bj < 2; ++bj) *(u32x4*)(base + (size_t)row * 2048 + bj * HALF) = pk8(acc[ai][bj][m][0], acc[ai][bj][m][1]); }
        } else if (wc == 0) {
#pragma unroll
            for (int ai = 0; ai < 2; ++ai)
#pragma unroll
                for (int m = 0; m < 4; ++m) { const int row = row0 + ai * HALF + m * 16; float* gp = G + (size_t)row * 32 + 8 * fq;
                    *(f32x4*)gp = acc[ai][0][m][0]; *(f32x4*)(gp + 4) = acc[ai][0][m][1]; }
        }
    }
};
}
#define LAS __attribute__((address_space(3)))
typedef unsigned short bf16;
typedef float f32x4 __attribute__((ext_vector_type(4)));
typedef unsigned u32x4 __attribute__((ext_vector_type(4)));
typedef unsigned u32x2 __attribute__((ext_vector_type(2)));
typedef short bf16x8 __attribute__((ext_vector_type(8)));
constexpr int DM = 2048, NB = 4, SEQL = 4096, CTXL = 256, MLAT = NB * SEQL, MCTX = NB * CTXL, MTOT = MLAT + MCTX, DFF = 8192;
constexpr float EPSN = 1e-6f;
constexpr size_t MiB = 1u << 20;
constexpr size_t WS_MOD = 0, WS_ROPE = 512 * 1024, WS_FFN1_0 = 1 * MiB, WS_FFN2_0 = 33 * MiB, WS_FFN1_1 = 65 * MiB, WS_FFN2_1 = 97 * MiB, WS_HYIN = 129 * MiB, WS_HYOUT = 149 * MiB,
                 WS_MLIN = 157 * MiB, WS_MLOUT = 182 * MiB, WS_XC = 190 * MiB, WS_H = 198 * MiB, WS_Y = 266 * MiB, WS_R = 402 * MiB,
                 WS_Q = WS_R, WS_K = WS_R + 34 * MiB, WS_V = WS_R + 68 * MiB, WS_UG = WS_R + 102 * MiB, WS_AO = WS_R + 136 * MiB, WS_HFF = WS_R,
                 WS_QKRAW = WS_R, WS_HF = WS_R, WS_V1 = WS_R + 68 * MiB, WS_AO1 = WS_R + 68 * MiB, WS_O1 = WS_R + 136 * MiB, WS_QKC = WS_R + 204 * MiB, WS_HB = WS_R + 272 * MiB,
                 WS_G = WS_R + 336 * MiB, WS_END = WS_R + 345 * MiB, WS_YP = WS_R + 272 * MiB, WS_SCP = WS_R + 339 * MiB, WS_SCH = WS_R + 344 * MiB;
constexpr size_t WS_BAR = 576 * 1024, WS_ZERO_BYTES = 640 * 1024;
constexpr int MODSZ = 5 * 12288;
constexpr int LDS_BYTES = 147456;

struct Params { const float* in[29]; float* out; unsigned char* ws; int ph_lo, ph_hi; };

__device__ __forceinline__ unsigned pk2(float lo, float hi) { typedef float f2 __attribute__((ext_vector_type(2))); typedef __bf16 b2 __attribute__((ext_vector_type(2))); f2 v = {lo, hi}; b2 b = __builtin_convertvector(v, b2); return __builtin_bit_cast(unsigned, b); }
__device__ __forceinline__ float bflo(unsigned w) { return __uint_as_float(w << 16); }
__device__ __forceinline__ float bfhi(unsigned w) { return __uint_as_float(w & 0xffff0000u); }
__device__ __forceinline__ float bf1(bf16 b) { return __uint_as_float((unsigned)b << 16); }
__device__ __forceinline__ float wave_sum(float v) {
#pragma unroll
    for (int o = 1; o < 64; o <<= 1) v += __shfl_xor(v, o);
    return v;
}
__device__ __forceinline__ float sigmf(float x) { return 1.0f / (1.0f + __expf(-x)); }

__device__ __forceinline__ int dst_row(int mode, int n) {
    if (mode == 1) {
        if (n < 2048) { const int d = n & 63, q = d >> 4, i = d & 15; const int dp = (q >> 1) * 32 + 2 * i + (q & 1); return (n & ~63) | dp; }
        if (n < 3072) return n;
        const int uu = n - 3072; return 3072 + 2 * (uu & 1023) + (uu >> 10);
    }
    if (mode == 2) {
        if (n < 4096) return n;
        if (n < 4128) return 6144 + (n - 4096);
        return 4096 + (n - 4128);
    }
    return n;
}
__device__ __forceinline__ void transpose_item(const float* W, int K, int N, bf16* WT, int mode, LAS float* scr, int item, int lane) {
    const int nblk = (N + 63) / 64, kb = item / nblk, nb = item % nblk, k0 = 64 * kb, n0 = 64 * nb;
    const bool okn = n0 + lane < N; const float* src = W + (size_t)k0 * N + n0 + lane;
    float t[64];
#pragma unroll
    for (int i = 0; i < 64; ++i) t[i] = okn ? src[(size_t)i * N] : 0.f;
#pragma unroll
    for (int i = 0; i < 64; ++i) scr[i * 65 + lane] = t[i];
    asm volatile("s_waitcnt lgkmcnt(0)" ::: "memory");
    const int c = lane & 7;
#pragma unroll
    for (int j = 0; j < 8; ++j) { const int n = (lane >> 3) + 8 * j; const LAS float* s = scr + (8 * c) * 65 + n;
        u32x4 o; o.x = pk2(s[0 * 65], s[1 * 65]); o.y = pk2(s[2 * 65], s[3 * 65]); o.z = pk2(s[4 * 65], s[5 * 65]); o.w = pk2(s[6 * 65], s[7 * 65]);
        if (n0 + n < N) *(u32x4*)(WT + (size_t)dst_row(mode, n0 + n) * K + k0 + 8 * c) = o; }
    asm volatile("s_waitcnt lgkmcnt(0)" ::: "memory");
}
__device__ __forceinline__ void ph_prologue(const Params& p, LAS unsigned char* lds) {
    const int tid = threadIdx.x, lane = tid & 63, wave = __builtin_amdgcn_readfirstlane(tid >> 6);
    const int gw = blockIdx.x * 8 + wave, NGW = gridDim.x * 8;
    LAS float* sl = (LAS float*)lds;
    LAS float* scr = (LAS float*)(lds + wave * 16640);
    { f32x4 cv[5];
#pragma unroll
      for (int q = 0; q < 5; ++q) { const int i4 = tid + 512 * q, s = i4 >> 9, k4 = i4 & 511; cv[q] = s < 4 ? *(const f32x4*)(p.in[1] + s * 2048 + 4 * k4) : *(const f32x4*)(p.in[3] + 4 * k4); }
#pragma unroll
      for (int q = 0; q < 5; ++q) { const int i4 = tid + 512 * q; f32x4 o;
#pragma unroll
        for (int e = 0; e < 4; ++e) o[e] = cv[q][e] / (1.0f + __expf(-cv[q][e]));
        *(LAS f32x4*)(sl + 4 * i4) = o; } }
    if (blockIdx.x == 0) {
        float* rope = (float*)(p.ws + WS_ROPE);
        for (int i = tid; i < 1024; i += 512) { const int pos = i >> 4, fi = i & 15; const double x = (double)exp2f(-(float)fi * 0.83048202372184058696f);
            double s = 0.0, c = 0.0, ts = x, tc = 1.0; const double x2 = x * x;
            for (int n = 0; n < 12; ++n) { c += tc; s += ts; tc = -tc * x2 / (double)((2 * n + 1) * (2 * n + 2)); ts = -ts * x2 / (double)((2 * n + 2) * (2 * n + 3)); }
            double cr = 1.0, sr = 0.0; for (int q = 0; q < pos; ++q) { const double nc = cr * c - sr * s, ns = sr * c + cr * s; cr = nc; sr = ns; }
            rope[2 * i] = (float)cr; rope[2 * i + 1] = (float)sr; }
    }
    __syncthreads();
    float* MOD = (float*)(p.ws + WS_MOD);
    for (int it = gw; it < 2 * 48 * 32; it += NGW) {
        const int l = it / 1536, r = it % 1536, ng = r >> 5, kc = r & 31, n = ng * 256 + 4 * lane;
        const float* W = p.in[4] + (size_t)l * 2048 * 12288 + (size_t)(kc * 64) * 12288 + n;
        f32x4 a0 = {0.f, 0.f, 0.f, 0.f}, a1 = a0, a2 = a0, a3 = a0, a4 = a0;
#pragma unroll 16
        for (int k = 0; k < 64; ++k) { const f32x4 w = *(const f32x4*)(W + (size_t)k * 12288); const int kk = kc * 64 + k;
            a0 += sl[kk] * w; a1 += sl[2048 + kk] * w; a2 += sl[4096 + kk] * w; a3 += sl[6144 + kk] * w; a4 += sl[8192 + kk] * w; }
        if (kc == 0) { const f32x4 b = *(const f32x4*)(p.in[5] + l * 12288 + n); a0 += b; a1 += b; a2 += b; a3 += b; a4 += b; }
        float* m = MOD + l * MODSZ + n;
#pragma unroll
        for (int e = 0; e < 4; ++e) {
            __hip_atomic_fetch_add(m + e, a0[e], __ATOMIC_RELAXED, __HIP_MEMORY_SCOPE_AGENT); __hip_atomic_fetch_add(m + 12288 + e, a1[e], __ATOMIC_RELAXED, __HIP_MEMORY_SCOPE_AGENT);
            __hip_atomic_fetch_add(m + 2 * 12288 + e, a2[e], __ATOMIC_RELAXED, __HIP_MEMORY_SCOPE_AGENT); __hip_atomic_fetch_add(m + 3 * 12288 + e, a3[e], __ATOMIC_RELAXED, __HIP_MEMORY_SCOPE_AGENT);
            __hip_atomic_fetch_add(m + 4 * 12288 + e, a4[e], __ATOMIC_RELAXED, __HIP_MEMORY_SCOPE_AGENT); }
    }
    __syncthreads();
    constexpr int I_F = 32 * 128, I_HI = 32 * 80, I_HO = 32 * 32, NIT = 2 * I_F + I_HI + I_HO;
    for (int it = gw; it < NIT; it += NGW) {
        int r = it;
        if (r < I_F) { transpose_item(p.in[10], 2048, 8192, (bf16*)(p.ws + WS_FFN1_0), 0, scr, r, lane); continue; } r -= I_F;
        if (r < I_F) { transpose_item(p.in[11], 8192, 2048, (bf16*)(p.ws + WS_FFN2_0), 0, scr, r, lane); continue; } r -= I_F;
        if (r < I_HI) { transpose_item(p.in[12], 2048, 5120, (bf16*)(p.ws + WS_HYIN), 1, scr, r, lane); continue; } r -= I_HI;
        transpose_item(p.in[13], 2048, 2048, (bf16*)(p.ws + WS_HYOUT), 0, scr, r, lane);
    }
}
__device__ __forceinline__ void tail_items(const Params& p, LAS unsigned char* lds, int nunits, int set) {
    const int G = gridDim.x, c = blockIdx.x, maxu = (nunits + G - 1) / G, nfull = nunits - (maxu - 1) * G;
    int idx = c, cnt = G;
    if (nfull != G) { if (c < nfull) return; idx = c - nfull; cnt = G - nfull; }
    const int lane = threadIdx.x & 63, wave = __builtin_amdgcn_readfirstlane(threadIdx.x >> 6), gw = idx * 8 + wave, NGW = cnt * 8;
    LAS float* scr = (LAS float*)(lds + wave * 16640);
    constexpr int I_F = 32 * 128, I_MI = 32 * 97, I_MO = 32 * 32;
    if (set == 0) { for (int it = gw; it < I_MI + I_MO + 1024; it += NGW) { if (it < I_MI) transpose_item(p.in[23], 2048, 6176, (bf16*)(p.ws + WS_MLIN), 2, scr, it, lane); else if (it < I_MI + I_MO) transpose_item(p.in[28], 2048, 2048, (bf16*)(p.ws + WS_MLOUT), 0, scr, it - I_MI, lane);
            else transpose_item(p.in[11] + (size_t)2048 * 8192, 8192, 2048, (bf16*)(p.ws + WS_FFN2_1), 0, scr, it - (I_MI + I_MO) + 3072, lane); } }
    else if (set == 1) { for (int it = gw; it < I_F; it += NGW) transpose_item(p.in[10] + (size_t)2048 * 8192, 2048, 8192, (bf16*)(p.ws + WS_FFN1_1), 0, scr, it, lane); }
    else { for (int it = gw; it < 3072; it += NGW) transpose_item(p.in[11] + (size_t)2048 * 8192, 8192, 2048, (bf16*)(p.ws + WS_FFN2_1), 0, scr, it, lane); }
}

template <class P4>
__device__ __forceinline__ void row_finish(const Params& p, int r, f32x4 (&v)[8], f32x4 (&y)[8], bool has_y, bool has_next, P4 gate, P4 gpost, P4 sh, P4 sc, P4 gnext, int lane) {
    float* XC = (float*)(p.ws + WS_XC); bf16* H = (bf16*)(p.ws + WS_H);
    const bool lat = r < MLAT;
    float* xout = lat ? (p.out + (size_t)r * DM) : (XC + (size_t)(r - MLAT) * DM);
    if (has_y) {
        float ss = 0.f;
#pragma unroll
        for (int j = 0; j < 8; ++j) ss += (y[j][0] * y[j][0] + y[j][1] * y[j][1]) + (y[j][2] * y[j][2] + y[j][3] * y[j][3]);
        const float rs = rsqrtf(wave_sum(ss) * (1.0f / DM) + EPSN);
#pragma unroll
        for (int j = 0; j < 8; ++j) { const int c = 4 * lane + 256 * j; const f32x4 g = gate[lane + 64 * j], gp = gpost[lane + 64 * j];
            v[j] += g * (y[j] * rs * gp); *(f32x4*)(xout + c) = v[j]; if (j & 1) asm volatile("" ::: "memory"); }
    }
    if (has_next) {
        float ss = 0.f;
#pragma unroll
        for (int j = 0; j < 8; ++j) ss += (v[j][0] * v[j][0] + v[j][1] * v[j][1]) + (v[j][2] * v[j][2] + v[j][3] * v[j][3]);
        const float rs = rsqrtf(wave_sum(ss) * (1.0f / DM) + EPSN);
#pragma unroll
        for (int j = 0; j < 8; ++j) { const int c = 4 * lane + 256 * j; const f32x4 a = sh[lane + 64 * j], b = sc[lane + 64 * j], g = gnext[lane + 64 * j];
            const f32x4 h = (v[j] * rs * g) * (1.0f + b) + a; u32x2 w; w.x = pk2(h[0], h[1]); w.y = pk2(h[2], h[3]); *(u32x2*)(H + (size_t)r * DM + c) = w; if (j & 1) asm volatile("" ::: "memory"); }
    }
}
__device__ __forceinline__ void ph_rows(const Params& p, LAS unsigned char* lds, int nrows, bool first, bool has_y, int lcur, int gate_idx, const float* gpost, bool has_next, int lnext, int shift_idx, const float* gnext, bool ctx_split = false) {
    const int lane = threadIdx.x & 63, wave = __builtin_amdgcn_readfirstlane(threadIdx.x >> 6), gw = blockIdx.x * 8 + wave, NGW = gridDim.x * 8;
    const float* MOD = (const float*)(p.ws + WS_MOD);
    const bf16* Y = (const bf16*)(p.ws + WS_Y); const float* XC = (const float*)(p.ws + WS_XC);
    const float* xl = first ? p.in[0] : p.out;
    LAS float* L = (LAS float*)lds;
    for (int i = threadIdx.x * 4; i < 2048; i += 2048) {
        if (has_y) *(LAS f32x4*)(L + i) = *(const f32x4*)(gpost + i);
        if (has_next) *(LAS f32x4*)(L + 2048 + i) = *(const f32x4*)(gnext + i);
#pragma unroll
        for (int s = 0; s < 4; ++s) {
            if (has_y) *(LAS f32x4*)(L + 4096 + 6144 * s + i) = *(const f32x4*)(MOD + lcur * MODSZ + s * 12288 + gate_idx * 2048 + i);
            if (has_next) { *(LAS f32x4*)(L + 4096 + 6144 * s + 2048 + i) = *(const f32x4*)(MOD + lnext * MODSZ + s * 12288 + shift_idx * 2048 + i);
                            *(LAS f32x4*)(L + 4096 + 6144 * s + 4096 + i) = *(const f32x4*)(MOD + lnext * MODSZ + s * 12288 + (shift_idx + 1) * 2048 + i); } }
    }
    __syncthreads();
    if (MLAT % (2 * NGW) == 0) {
        f32x4 ax[8], bx[8]; u32x2 ay[8], by[8];
#pragma unroll
        for (int j = 0; j < 8; ++j) { ay[j] = (u32x2){0u, 0u}; by[j] = ay[j];
            ax[j] = *(const f32x4*)(xl + (size_t)gw * DM + 4 * lane + 256 * j); if (has_y) ay[j] = *(const u32x2*)(Y + (size_t)gw * DM + 4 * lane + 256 * j); }
#pragma unroll
        for (int j = 0; j < 8; ++j) { bx[j] = *(const f32x4*)(xl + (size_t)(gw + NGW) * DM + 4 * lane + 256 * j); if (has_y) by[j] = *(const u32x2*)(Y + (size_t)(gw + NGW) * DM + 4 * lane + 256 * j); }
        for (int r = gw; r < MLAT; r += 2 * NGW) {
            { f32x4 v[8], y[8];
#pragma unroll
              for (int j = 0; j < 8; ++j) { v[j] = ax[j]; y[j] = (f32x4){bflo(ay[j].x), bfhi(ay[j].x), bflo(ay[j].y), bfhi(ay[j].y)}; }
              const int rn = (r + 2 * NGW < MLAT) ? r + 2 * NGW : r;
#pragma unroll
              for (int j = 0; j < 8; ++j) { ax[j] = *(const f32x4*)(xl + (size_t)rn * DM + 4 * lane + 256 * j); if (has_y) ay[j] = *(const u32x2*)(Y + (size_t)rn * DM + 4 * lane + 256 * j); }
              const LAS f32x4* Ls = (const LAS f32x4*)(L + 4096 + 6144 * (r >> 12));
              row_finish<const LAS f32x4*>(p, r, v, y, has_y, has_next, Ls, (const LAS f32x4*)L, Ls + 512, Ls + 1024, (const LAS f32x4*)(L + 2048), lane); }
            { const int r2 = r + NGW; f32x4 v[8], y[8];
#pragma unroll
              for (int j = 0; j < 8; ++j) { v[j] = bx[j]; y[j] = (f32x4){bflo(by[j].x), bfhi(by[j].x), bflo(by[j].y), bfhi(by[j].y)}; }
              const int rn = (r2 + 2 * NGW < MLAT) ? r2 + 2 * NGW : r2;
#pragma unroll
              for (int j = 0; j < 8; ++j) { bx[j] = *(const f32x4*)(xl + (size_t)rn * DM + 4 * lane + 256 * j); if (has_y) by[j] = *(const u32x2*)(Y + (size_t)rn * DM + 4 * lane + 256 * j); }
              const LAS f32x4* Ls = (const LAS f32x4*)(L + 4096 + 6144 * (r2 >> 12));
              row_finish<const LAS f32x4*>(p, r2, v, y, has_y, has_next, Ls, (const LAS f32x4*)L, Ls + 512, Ls + 1024, (const LAS f32x4*)(L + 2048), lane); }
        }
    } else {
    f32x4 nx[8]; u32x2 ny[8];
#pragma unroll
    for (int j = 0; j < 8; ++j) { nx[j] = (f32x4){0.f, 0.f, 0.f, 0.f}; ny[j] = (u32x2){0u, 0u}; }
    if (gw < MLAT) {
#pragma unroll
        for (int j = 0; j < 8; ++j) { nx[j] = *(const f32x4*)(xl + (size_t)gw * DM + 4 * lane + 256 * j); if (has_y) ny[j] = *(const u32x2*)(Y + (size_t)gw * DM + 4 * lane + 256 * j); } }
    for (int r = gw; r < MLAT; r += NGW) {
        f32x4 v[8], y[8];
#pragma unroll
        for (int j = 0; j < 8; ++j) { v[j] = nx[j]; y[j] = (f32x4){bflo(ny[j].x), bfhi(ny[j].x), bflo(ny[j].y), bfhi(ny[j].y)}; }
        const int rn = (r + NGW < MLAT) ? r + NGW : r;
#pragma unroll
        for (int j = 0; j < 8; ++j) { nx[j] = *(const f32x4*)(xl + (size_t)rn * DM + 4 * lane + 256 * j); if (has_y) ny[j] = *(const u32x2*)(Y + (size_t)rn * DM + 4 * lane + 256 * j); }
        const LAS f32x4* Ls = (const LAS f32x4*)(L + 4096 + 6144 * (r >> 12));
        row_finish<const LAS f32x4*>(p, r, v, y, has_y, has_next, Ls, (const LAS f32x4*)L, Ls + 512, Ls + 1024, (const LAS f32x4*)(L + 2048), lane);
    }
    }
    for (int r = MLAT + gw; r < nrows; r += NGW) {
        const float* xin = (first ? p.in[2] : XC) + (size_t)(r - MLAT) * DM;
        f32x4 v[8], y[8];
#pragma unroll
        for (int j = 0; j < 8; ++j) v[j] = *(const f32x4*)(xin + 4 * lane + 256 * j);
        if (has_y) {
            if (ctx_split) {
#pragma unroll
                for (int j = 0; j < 8; ++j) y[j] = (f32x4){0.f, 0.f, 0.f, 0.f};
#pragma unroll 1
                for (int ks = 0; ks < 8; ++ks) { const float* yp = (const float*)(p.ws + WS_YP) + (size_t)ks * MCTX * DM + (size_t)(r - MLAT) * DM + 4 * lane;
#pragma unroll
                    for (int j = 0; j < 8; ++j) y[j] += *(const f32x4*)(yp + 256 * j); } }
            else {
#pragma unroll
                for (int j = 0; j < 8; ++j) { const u32x2 yw = *(const u32x2*)(Y + (size_t)r * DM + 4 * lane + 256 * j); y[j] = (f32x4){bflo(yw.x), bfhi(yw.x), bflo(yw.y), bfhi(yw.y)}; } } }
        else {
#pragma unroll
            for (int j = 0; j < 8; ++j) y[j] = (f32x4){0.f, 0.f, 0.f, 0.f}; }
        const float* gm = MOD + lcur * MODSZ + 4 * 12288 + gate_idx * 2048; const float* sm = MOD + lnext * MODSZ + 4 * 12288 + shift_idx * 2048;
        row_finish<const f32x4*>(p, r, v, y, has_y, has_next, (const f32x4*)gm, (const f32x4*)gpost, (const f32x4*)sm, (const f32x4*)(sm + 2048), (const f32x4*)gnext, lane);
    }
}
#define RLX_AGENT __ATOMIC_RELAXED, __HIP_MEMORY_SCOPE_AGENT
#define LDS_WAIT() asm volatile("s_waitcnt lgkmcnt(0)" ::: "memory")
#define XB_TMO      128
#define XB_XCNT(j)  (256  + 64 * (j))
#define XB_XSUB(j)  (1280 + 64 * (j))
#define XB_XGEN(j)  (2304 + 64 * (j))
#define XB_TOP      3328
#define XB_TOPGEN   3392
#define XCD_BAR_WORDS 3456
#define XB_SPIN_CAP (1u << 18)

__device__ __forceinline__ unsigned xb_ld(unsigned* p)              { return __hip_atomic_load(p, __ATOMIC_RELAXED, __HIP_MEMORY_SCOPE_AGENT); }
__device__ __forceinline__ unsigned xb_add(unsigned* p, unsigned v) { return __hip_atomic_fetch_add(p, v, __ATOMIC_RELAXED, __HIP_MEMORY_SCOPE_AGENT); }
__device__ __forceinline__ unsigned xb_xcc_id() { return (unsigned)__builtin_amdgcn_s_getreg((3 << 11) | 20) & 0xFu; }
#define XB_SPIN(cond, bar) do { unsigned _sp = 0; while (cond) { __builtin_amdgcn_s_sleep(1); \
    if ((++_sp & 255u) == 0u) { if (xb_ld(&(bar)[XB_TMO])) break; if (_sp > XB_SPIN_CAP) { atomicAdd(&(bar)[XB_TMO], 1u); break; } } } } while (0)

struct XcdBarrier {
    unsigned* bar; unsigned x;
    volatile LAS unsigned* st;
};

__device__ __forceinline__ XcdBarrier xcd_barrier_post(unsigned* bar, volatile LAS unsigned* st) {
    XcdBarrier b; b.bar = bar; b.x = xb_xcc_id(); b.st = st;
    if (threadIdx.x == 0) (void)xb_add(&bar[XB_XCNT(b.x)], 1u);
    return b;
}
__device__ __forceinline__ void xcd_barrier_complete(unsigned* bar, unsigned x, unsigned& nloc, unsigned& nx) {
    const unsigned G = gridDim.x * gridDim.y * gridDim.z;
    unsigned sum, cnt, mine, sp = 0u;
    for (;;) {
        sum = 0u; cnt = 0u; mine = 0u;
#pragma unroll
        for (unsigned j = 0; j < 16; ++j) { const unsigned c = xb_ld(&bar[XB_XCNT(j)]); sum += c; cnt += (c > 0u) ? 1u : 0u; mine = (j == x) ? c : mine; }
        if (sum == G) break;
        __builtin_amdgcn_s_sleep(1);
        if ((++sp & 255u) == 0u) { if (xb_ld(&bar[XB_TMO])) break; if (sp > XB_SPIN_CAP) { atomicAdd(&bar[XB_TMO], 1u); break; } }
    }
    nloc = mine > 0u ? mine : 1u; nx = cnt > 0u ? cnt : 1u;
}

__device__ __forceinline__ void xcd_barrier(const XcdBarrier& b) {
    asm volatile("s_waitcnt vmcnt(0)" ::: "memory");
    __syncthreads();
    if (threadIdx.x == 0) {
        unsigned* bar = b.bar;
        __builtin_amdgcn_s_waitcnt(0);
        unsigned nloc = b.st[0], nx = b.st[1];
        if (nloc == 0u) { xcd_barrier_complete(bar, b.x, nloc, nx); b.st[0] = nloc; b.st[1] = nx; }
        const unsigned old = xb_add(&bar[XB_XSUB(b.x)], 1u);
        const unsigned gen = old / nloc;
        if (old + 1u == (gen + 1u) * nloc) {
            __builtin_amdgcn_fence(__ATOMIC_RELEASE, "agent");
            asm volatile("s_waitcnt vmcnt(0)" ::: "memory");
            const unsigned og = xb_add(&bar[XB_TOP], 1u);
            const unsigned tg = og / nx;
            if (og + 1u == (tg + 1u) * nx) xb_add(&bar[XB_TOPGEN], 1u);
            else XB_SPIN(xb_ld(&bar[XB_TOPGEN]) == tg, bar);
            __builtin_amdgcn_fence(__ATOMIC_ACQUIRE, "agent");
            xb_add(&bar[XB_XGEN(b.x)], 1u);
            asm volatile("s_waitcnt vmcnt(0)" ::: "memory");
        } else {
            XB_SPIN(xb_ld(&bar[XB_XGEN(b.x)]) == gen, bar);
            __builtin_amdgcn_fence(__ATOMIC_ACQUIRE, "agent");
            asm volatile("s_waitcnt vmcnt(0)" ::: "memory");
        }
    }
    __syncthreads();
}
namespace att {
using f32x16 = __attribute__((ext_vector_type(16))) float;
using s16x4 = __attribute__((ext_vector_type(4))) short;
constexpr float SCALE = 0.125f, THR = 8.f;
constexpr int SHM_V = 64 * 128 * 2, SHM_K = 64 * 128 * 2;
#define KSWZ(row, colB) ((row) * 256 + ((colB) ^ (((row) & 15) << 4)))
#define SBAR() __builtin_amdgcn_sched_barrier(0)
__device__ __forceinline__ int crow(int r, int hi) { return (r & 3) + 8 * (r >> 2) + 4 * hi; }
__device__ __forceinline__ unsigned cvtpk(float lo, float hi) { unsigned r; asm volatile("v_cvt_pk_bf16_f32 %0, %1, %2" : "=v"(r) : "v"(lo), "v"(hi)); return r; }
__device__ __forceinline__ void partialSM(f32x16& p0, f32x16& p1, float& m_reg, float& mn, float& alpha) {
  constexpr float C = SCALE * 1.4426950408889634f;
  float pmax = p0[0];
#pragma unroll
  for (int r = 1; r < 16; ++r) pmax = fmaxf(pmax, p0[r]);
#pragma unroll
  for (int r = 0; r < 16; ++r) pmax = fmaxf(pmax, p1[r]);
  { auto rr = __builtin_amdgcn_permlane32_swap(__float_as_uint(pmax), __float_as_uint(pmax), false, false);
    pmax = fmaxf(__uint_as_float(rr[0]), __uint_as_float(rr[1])); }
  if (__builtin_expect(__all(pmax - m_reg <= THR / SCALE), 1)) { mn = m_reg; alpha = 1.f; }
  else { mn = fmaxf(m_reg, pmax); alpha = __builtin_amdgcn_exp2f((m_reg - mn) * C); m_reg = mn; }
  float mnC = -mn * C;
#pragma unroll
  for (int r = 0; r < 16; ++r) p0[r] = fmaf(p0[r], C, mnC);
#pragma unroll
  for (int r = 0; r < 16; ++r) p1[r] = fmaf(p1[r], C, mnC);
#pragma unroll
  for (int r = 0; r < 16; ++r) p0[r] = __builtin_amdgcn_exp2f(p0[r]);
}
__device__ __forceinline__ void finishSM(f32x16& p0, f32x16& p1, float alpha, float& l_reg, bf16x8& pa0, bf16x8& pa1, bf16x8& pa2, bf16x8& pa3) {
#pragma unroll
  for (int r = 0; r < 16; ++r) p1[r] = __builtin_amdgcn_exp2f(p1[r]);
  float ps = 0;
#pragma unroll
  for (int r = 0; r < 16; ++r) ps += p0[r];
#pragma unroll
  for (int r = 0; r < 16; ++r) ps += p1[r];
  { auto rr = __builtin_amdgcn_permlane32_swap(__float_as_uint(ps), __float_as_uint(ps), false, false);
    ps = __uint_as_float(rr[0]) + __uint_as_float(rr[1]); }
  l_reg = l_reg * alpha + ps;
#define PK4(P, BASE, OUT) do { unsigned a0 = cvtpk(P[BASE + 0], P[BASE + 1]), a1 = cvtpk(P[BASE + 2], P[BASE + 3]);   \
    unsigned b0 = cvtpk(P[BASE + 4], P[BASE + 5]), b1 = cvtpk(P[BASE + 6], P[BASE + 7]);                              \
    auto r0 = __builtin_amdgcn_permlane32_swap(a0, b0, false, false); auto r1 = __builtin_amdgcn_permlane32_swap(a1, b1, false, false); \
    u32x4 w = {r0[0], r1[0], r0[1], r1[1]}; OUT = *reinterpret_cast<bf16x8*>(&w); } while (0)
  PK4(p0, 0, pa0); PK4(p0, 8, pa1); PK4(p1, 0, pa2); PK4(p1, 8, pa3);
#undef PK4
}
__device__ __forceinline__ void qkt(f32x16& p0, f32x16& p1, const char* Ks, const bf16x8* qr, int r32, int hi, int comp) {
  p0 = f32x16{}; p1 = f32x16{};
#pragma unroll
  for (int d0 = 0; d0 < 4; ++d0) { const int cb = ((comp * 4 + d0) * 16 + hi * 8) * 2;
    bf16x8 b0 = *reinterpret_cast<const bf16x8*>(Ks + KSWZ(r32, cb));
    bf16x8 b1 = *reinterpret_cast<const bf16x8*>(Ks + KSWZ(32 + r32, cb));
    p0 = __builtin_amdgcn_mfma_f32_32x32x16_bf16(b0, qr[d0], p0, 0, 0, 0);
    p1 = __builtin_amdgcn_mfma_f32_32x32x16_bf16(b1, qr[d0], p1, 0, 0, 0); }
}
__device__ __forceinline__ int v_st(int k, int c) { const int kk = (k & ~0xC) | ((k & 4) << 1) | ((k & 8) >> 1); return ((kk >> 3) * 4 + (c >> 5)) * 512 + ((kk & 7) * 32 + (c & 31)) * 2; }
__device__ __forceinline__ int v_rd_base(int lane) { return ((lane & 3) << 3) | (((lane >> 2) & 3) << 6) | (((lane >> 4) & 1) << 5) | (((lane >> 5) & 1) << 8); }
constexpr int v_rd_off(int d0, int ks, int half) { return d0 * 512 + ks * 4096 + half * 2048; }
template <int OFF> __device__ __forceinline__ s16x4 tr_read(int vb) {
  s16x4 r; asm volatile("ds_read_b64_tr_b16 %0, %1 offset:%2" : "=&v"(r) : "v"(vb), "i"(OFF) : "memory"); return r;
}
template <int D0> __device__ __forceinline__ void pv_one(f32x16& od, int vb, bf16x8 pa0, bf16x8 pa1, bf16x8 pa2, bf16x8 pa3) {
  const s16x4 l0 = tr_read<v_rd_off(D0, 0, 0)>(vb), h0 = tr_read<v_rd_off(D0, 0, 1)>(vb), l1 = tr_read<v_rd_off(D0, 1, 0)>(vb), h1 = tr_read<v_rd_off(D0, 1, 1)>(vb);
  const s16x4 l2 = tr_read<v_rd_off(D0, 2, 0)>(vb), h2 = tr_read<v_rd_off(D0, 2, 1)>(vb), l3 = tr_read<v_rd_off(D0, 3, 0)>(vb), h3 = tr_read<v_rd_off(D0, 3, 1)>(vb);
  asm volatile("s_waitcnt lgkmcnt(0)" ::: "memory"); SBAR();
#define PK(L, H) (bf16x8){L[0], L[1], L[2], L[3], H[0], H[1], H[2], H[3]}
  od = __builtin_amdgcn_mfma_f32_32x32x16_bf16(pa0, PK(l0, h0), od, 0, 0, 0);
  od = __builtin_amdgcn_mfma_f32_32x32x16_bf16(pa1, PK(l1, h1), od, 0, 0, 0);
  od = __builtin_amdgcn_mfma_f32_32x32x16_bf16(pa2, PK(l2, h2), od, 0, 0, 0);
  od = __builtin_amdgcn_mfma_f32_32x32x16_bf16(pa3, PK(l3, h3), od, 0, 0, 0);
#undef PK
}
__device__ __forceinline__ void pv_d0(f32x16* o, int vb, bf16x8 pa0, bf16x8 pa1, bf16x8 pa2, bf16x8 pa3) {
  pv_one<0>(o[0], vb, pa0, pa1, pa2, pa3); pv_one<1>(o[1], vb, pa0, pa1, pa2, pa3); pv_one<2>(o[2], vb, pa0, pa1, pa2, pa3); pv_one<3>(o[3], vb, pa0, pa1, pa2, pa3);
}
__device__ __forceinline__ void attn_unit(const bf16* __restrict__ Qg, const bf16* __restrict__ Kg, const bf16* __restrict__ Vg, bf16* __restrict__ AO,
                                          int b, int h, int qrow0, int NT, float lam, const float* __restrict__ subg, char* lds) {
  const int tid = threadIdx.x, wid = tid >> 6, lane = tid & 63, r32 = lane & 31, hi = lane >> 5, comp = wid >> 2, wq = wid & 3;
  char* V_lds = lds; char* K_lds = lds + 2 * SHM_V;
  float* ws = (float*)(lds + 2 * SHM_V + 2 * SHM_K) + wid * 64; float* li_l = ws; float* al_l = ws + 32;
  float m_reg = -1e30f, l_reg = 0; f32x16 o[4] = {}; bf16x8 qr[4];
  const bf16* Qw = Qg + (size_t)(qrow0 + wq * 32 + r32) * 1024 + h * 128 + comp * 64 + hi * 8;
#pragma unroll
  for (int d0 = 0; d0 < 4; ++d0) qr[d0] = *reinterpret_cast<const bf16x8*>(Qw + d0 * 16);
  const int sr = tid >> 4, sc = (tid & 15) * 8, vst0 = v_st(sr, sc), vst1 = v_st(32 + sr, sc);
  const int vb0 = (int)(uintptr_t)V_lds + v_rd_base(lane);
  struct { bf16x8 vs0, vs1, ks0, ks1; } sr_[2];
  const int kctx = MLAT + b * 256, klat = b * 4096 - 256;
#define KROW(j) (((j) < 4 ? kctx : klat) + (j) * 64)
#define SLOAD(i, j) do { const size_t r0_ = (size_t)(KROW(j) + sr) * 1024 + h * 128 + sc; \
    sr_[i].vs0 = *reinterpret_cast<const bf16x8*>(Vg + r0_); sr_[i].vs1 = *reinterpret_cast<const bf16x8*>(Vg + r0_ + 32 * 1024); \
    sr_[i].ks0 = *reinterpret_cast<const bf16x8*>(Kg + r0_); sr_[i].ks1 = *reinterpret_cast<const bf16x8*>(Kg + r0_ + 32 * 1024); } while (0)
#define SWRITE(bb, i) do { *(bf16x8*)(V_lds + (bb) * SHM_V + vst0) = sr_[i].vs0; *(bf16x8*)(V_lds + (bb) * SHM_V + vst1) = sr_[i].vs1; const int kc = sc * 2; \
    *(bf16x8*)(K_lds + (bb) * SHM_K + KSWZ(sr, kc)) = sr_[i].ks0; *(bf16x8*)(K_lds + (bb) * SHM_K + KSWZ(32 + sr, kc)) = sr_[i].ks1; } while (0)
#define SWAIT() asm volatile("s_waitcnt vmcnt(4)" ::: "memory")
#define RESC(a) do { if (__any((a) < 1.f)) { if (hi == 0) al_l[r32] = (a); asm volatile("s_waitcnt lgkmcnt(0)" ::: "memory"); \
    _Pragma("unroll") for (int d = 0; d < 4; ++d) _Pragma("unroll") for (int r = 0; r < 16; ++r) o[d][r] *= al_l[crow(r, hi)]; } } while (0)
  f32x16 pA0, pA1, pB0, pB1; float mnA, mnB, alA, alB; bf16x8 pa0, pa1, pa2, pa3;
  constexpr int SE = 0, SO = 1;
  SLOAD(SE, 0); asm volatile("s_waitcnt vmcnt(0)" ::: "memory"); SWRITE(0, SE); __syncthreads();
  qkt(pA0, pA1, K_lds, qr, r32, hi, comp); partialSM(pA0, pA1, m_reg, mnA, alA);
  SLOAD(SO, 1); if (2 < NT) SLOAD(SE, 2);
  SWAIT(); SWRITE(1, SO); __syncthreads();
  for (int j = 1; j + 1 < NT; j += 2) {
    SBAR(); qkt(pB0, pB1, K_lds + SHM_K, qr, r32, hi, comp);
    finishSM(pA0, pA1, alA, l_reg, pa0, pa1, pa2, pa3); SBAR();
    SLOAD(SO, j + 2); SBAR();
    pv_d0(o, vb0, pa0, pa1, pa2, pa3); partialSM(pB0, pB1, m_reg, mnB, alB);
    __syncthreads(); SWAIT(); SWRITE(0, SE);
    RESC(alB); __syncthreads();
    SBAR(); qkt(pA0, pA1, K_lds, qr, r32, hi, comp);
    finishSM(pB0, pB1, alB, l_reg, pa0, pa1, pa2, pa3); SBAR();
    SLOAD(SE, (j + 3 < NT) ? j + 3 : NT - 1); SBAR();
    pv_d0(o, vb0 + SHM_V, pa0, pa1, pa2, pa3); partialSM(pA0, pA1, m_reg, mnA, alA);
    __syncthreads(); SWAIT(); SWRITE(1, SO);
    RESC(alA); __syncthreads();
  }
  SBAR(); qkt(pB0, pB1, K_lds + SHM_K, qr, r32, hi, comp);
  finishSM(pA0, pA1, alA, l_reg, pa0, pa1, pa2, pa3); SBAR();
  pv_d0(o, vb0, pa0, pa1, pa2, pa3); partialSM(pB0, pB1, m_reg, mnB, alB);
  __syncthreads(); RESC(alB);
  finishSM(pB0, pB1, alB, l_reg, pa0, pa1, pa2, pa3); SBAR();
  pv_d0(o, vb0 + SHM_V, pa0, pa1, pa2, pa3);
  if (hi == 0) li_l[r32] = l_reg; asm volatile("s_waitcnt lgkmcnt(0)" ::: "memory");
  float rli[16]; const float sgn = comp ? -lam : 1.0f;
#pragma unroll
  for (int r = 0; r < 16; ++r) rli[r] = __builtin_amdgcn_rcpf(li_l[crow(r, hi)]) * sgn;
  __syncthreads();
  float* ex = (float*)lds + (size_t)wq * 4096 + lane;
  if (comp == 1) {
#pragma unroll
    for (int d0 = 0; d0 < 4; ++d0)
#pragma unroll
      for (int r = 0; r < 16; ++r) ex[(d0 * 16 + r) * 64] = o[d0][r] * rli[r];
  }
  __syncthreads();
  if (comp == 0) {
    float ss[16];
#pragma unroll
    for (int r = 0; r < 16; ++r) { float s = 0.f;
#pragma unroll
      for (int d0 = 0; d0 < 4; ++d0) { const float v = o[d0][r] * rli[r] + ex[(d0 * 16 + r) * 64]; o[d0][r] = v; s += v * v; }
      ss[r] = s; }
#pragma unroll
    for (int off = 1; off < 32; off <<= 1)
#pragma unroll
      for (int r = 0; r < 16; ++r) ss[r] += __shfl_xor(ss[r], off);
    float g[4];
#pragma unroll
    for (int d0 = 0; d0 < 4; ++d0) g[d0] = subg[32 * d0 + r32] * 0.8f;
    bf16* Ow = AO + (size_t)(qrow0 + wq * 32) * 2048 + h * 128 + r32;
#pragma unroll
    for (int r = 0; r < 16; ++r) { const float rs = rsqrtf(ss[r] * (1.0f / 128.f) + EPSN); const int orow = crow(r, hi);
#pragma unroll
      for (int d0 = 0; d0 < 4; ++d0) Ow[(size_t)orow * 2048 + d0 * 32] = (bf16)(pk2(o[d0][r] * rs * g[d0], 0.f) & 0xffffu); }
  }
  __syncthreads();
#undef KROW
#undef SLOAD
#undef SWRITE
#undef SWAIT
#undef RESC
}
#undef SBAR
#undef KSWZ
}

__device__ __forceinline__ void conv_item(const Params& p, int item, char* lds) {
  const int tid = threadIdx.x, lane = tid & 63, wave = tid >> 6, r0 = item * 16, c0 = 2 * tid;
  int s0, s1; if (r0 < MLAT) { s0 = r0 & ~4095; s1 = s0 + 4096; } else { s0 = MLAT + ((r0 - MLAT) & ~255); s1 = s0 + 256; }
  const bf16* UG = (const bf16*)(p.ws + WS_UG); bf16* AO = (bf16*)(p.ws + WS_AO);
  float* red = (float*)lds; float* stat = red + 256;
  float o0[16], o1[16];
#pragma unroll
  for (int t = 0; t < 16; ++t) { o0[t] = 0.f; o1[t] = 0.f; }
  {
    float w0[31], w1[31];
#pragma unroll
    for (int j = 0; j < 31; ++j) { const float2 w = *(const float2*)(p.in[19] + j * 1024 + c0); w0[j] = w.x; w1[j] = w.y; }
#pragma unroll
    for (int rr = 0; rr < 46; ++rr) { const int row = r0 - 15 + rr; unsigned xw = 0u;
      if (row >= s0 && row < s1) xw = *(const unsigned*)(UG + (size_t)row * 1024 + c0);
      const float x0 = bflo(xw), x1 = bfhi(xw);
#pragma unroll
      for (int t = 0; t < 16; ++t) { const int j = rr - t; if (j >= 0 && j <= 30) { o0[t] = fmaf(w0[j], x0, o0[t]); o1[t] = fmaf(w1[j], x1, o1[t]); } } }
  }
  const float2 cb = *(const float2*)(p.in[20] + c0);
  float v[32];
#pragma unroll
  for (int t = 0; t < 16; ++t) { o0[t] += cb.x; o1[t] += cb.y; v[t] = o0[t] + o1[t]; v[16 + t] = o0[t] * o0[t] + o1[t] * o1[t]; }
#pragma unroll
  for (int S = 16; S >= 1; S >>= 1) {
    const bool up = (lane & S) != 0;
#pragma unroll
    for (int k = 0; k < S; ++k) { const float a = v[k], bq = v[k + S]; const float keep = up ? bq : a, send = up ? a : bq; v[k] = keep + __shfl_xor(send, S); }
  }
  v[0] += __shfl_xor(v[0], 32);
  __syncthreads();
  if (lane < 32) red[wave * 32 + lane] = v[0];
  __syncthreads();
  if (tid < 16) { float S1 = 0.f, S2 = 0.f;
#pragma unroll
    for (int w = 0; w < 8; ++w) { S1 += red[w * 32 + tid]; S2 += red[w * 32 + 16 + tid]; }
    const float mean = S1 * (1.0f / 1024.f), var = fmaxf(S2 * (1.0f / 1024.f) - mean * mean, 0.f);
    stat[2 * tid] = mean; stat[2 * tid + 1] = rsqrtf(var + EPSN); }
  __syncthreads();
  const float2 lg = *(const float2*)(p.in[21] + c0), lb = *(const float2*)(p.in[22] + c0);
#pragma unroll
  for (int t = 0; t < 16; ++t) { const float mean = stat[2 * t], rstd = stat[2 * t + 1];
    float a = (o0[t] - mean) * rstd * lg.x + lb.x, bq = (o1[t] - mean) * rstd * lg.y + lb.y; a = a * sigmf(a); bq = bq * sigmf(bq);
    *(unsigned*)(AO + (size_t)(r0 + t) * 2048 + 1024 + c0) = pk2(a, bq); }
}
__device__ __forceinline__ void ph_mix0(const Params& p, char* lds) {
  const int G = gridDim.x, bx = blockIdx.x;
#ifndef NO_CONV
  for (int it = bx; it < MTOT / 16; it += G) conv_item(p, it, lds);
#endif
  __syncthreads();
  float lam;
  { float s1 = 0.f, s2 = 0.f; for (int i = 0; i < 64; ++i) { s1 += p.in[14][i] * p.in[15][i]; s2 += p.in[16][i] * p.in[17][i]; } lam = __expf(s1) - __expf(s2) + 0.2f; }
  const bf16* Qg = (const bf16*)(p.ws + WS_Q); const bf16* Kg = (const bf16*)(p.ws + WS_K); const bf16* Vg = (const bf16*)(p.ws + WS_V); bf16* AO = (bf16*)(p.ws + WS_AO);
#ifndef NO_ATT
  for (int u = bx; u < 1024 + 64; u += G) {
    if (u >= 1024 && G >= 128) break;
    if (u < 1024) { int bh = u >> 5, qb = u & 31; if (G == 256) { bh = (u >> 8) * 8 + (bx & 7); qb = bx >> 3; }
      const int b = bh >> 3, h = bh & 7; att::attn_unit(Qg, Kg, Vg, AO, b, h, b * 4096 + qb * 128, 68, lam, p.in[18], lds); }
    else { const int c = u - 1024, b = c >> 4, h = (c >> 1) & 7, hf = c & 1; att::attn_unit(Qg, Kg, Vg, AO, b, h, MLAT + b * 256 + hf * 128, 4, lam, p.in[18], lds); }
  }
  if (G >= 128 && bx >= G - 64) { const int c = bx - (G - 64), b = c >> 4, h = (c >> 1) & 7, hf = c & 1; att::attn_unit(Qg, Kg, Vg, AO, b, h, MLAT + b * 256 + hf * 128, 4, lam, p.in[18], lds); }
#endif
}
__device__ __forceinline__ float wscan_add(float v, int lane) {
#pragma unroll
  for (int o = 1; o < 64; o <<= 1) { const float t = __shfl_up(v, o); if (lane >= o) v += t; }
  return v;
}
__device__ __forceinline__ float wscan_max(float v, int lane) {
#pragma unroll
  for (int o = 1; o < 64; o <<= 1) { const float t = __shfl_up(v, o); if (lane >= o) v = fmaxf(v, t); }
  return v;
}
__device__ __forceinline__ int ml_row(int b, int dir, int s, int i) {
  return s < 4 ? (dir ? (MLAT + b * 256 + 255 - 64 * s - i) : (MLAT + b * 256 + 64 * s + i)) : (dir ? (b * 4096 + 4095 - 64 * (s - 4) - i) : (b * 4096 + 64 * (s - 4) + i));
}
__device__ __forceinline__ void ph_mlconv(const Params& p) {
  const bf16* QK = (const bf16*)(p.ws + WS_QKRAW); bf16* QC = (bf16*)(p.ws + WS_QKC);
  const float* cw = p.in[24]; const float* cbias = p.in[25];
  { const int lane = threadIdx.x & 63, gw = blockIdx.x * 8 + __builtin_amdgcn_readfirstlane(threadIdx.x >> 6), NGW = gridDim.x * 8;
    const float* G = (const float*)(p.ws + WS_G); f32x4* P = (f32x4*)(p.ws + WS_SCP); float* CH = (float*)(p.ws + WS_SCH);
    for (int it = gw; it < 64 * 68; it += NGW) { const int task = it / 68, s = it % 68, dir = task & 1, h = (task >> 1) & 7, b = task >> 4;
      const int gci = dir * 16 + h, gcf = gci + 8, row = ml_row(b, dir, s, lane);
      const float ig = G[(size_t)row * 32 + gci] + p.in[26][gci], fr = G[(size_t)row * 32 + gcf] + p.in[26][gcf];
      const float lf = fminf(fr, 0.f) - log1pf(__expf(-fabsf(fr))), bc = wscan_add(lf, lane), a = ig - bc, am = wscan_max(a, lane);
      P[(size_t)task * 4352 + 64 * s + lane] = (f32x4){a, am, bc, 0.f};
      if (lane == 63) { CH[(task * 68 + s) * 2] = bc; CH[(task * 68 + s) * 2 + 1] = am; } } }
  const int stride = gridDim.x * 512;
  for (int idx = blockIdx.x * 512 + threadIdx.x; idx < (MTOT / 8) * 256; idx += stride) {
    const int r0 = (idx >> 8) * 8, c = (idx & 255) * 8;
    int s0, s1; if (r0 < MLAT) { s0 = r0 & ~4095; s1 = s0 + 4096; } else { s0 = MLAT + ((r0 - MLAT) & ~255); s1 = s0 + 256; }
    const u32x4 z = {0u, 0u, 0u, 0u}; u32x4 x[10];
#pragma unroll
    for (int i = 0; i < 10; ++i) { const int r = r0 - 1 + i; x[i] = (r >= s0 && r < s1) ? *(const u32x4*)(QK + (size_t)r * 2048 + c) : z; }
    float w0[8], w1[8], w2[8], bb[8];
#pragma unroll
    for (int e = 0; e < 8; ++e) { w0[e] = cw[c + e]; w1[e] = cw[2048 + c + e]; w2[e] = cw[4096 + c + e]; bb[e] = cbias[c + e]; }
    const float ksc = (c >= 1024) ? 0.08838834764831845f : 1.0f;
#pragma unroll
    for (int i = 0; i < 8; ++i) { float y[8];
#pragma unroll
      for (int e = 0; e < 8; ++e) { const unsigned wm = x[i][e >> 1], wc = x[i + 1][e >> 1], wp = x[i + 2][e >> 1];
        const float a = (e & 1) ? bfhi(wm) : bflo(wm), b = (e & 1) ? bfhi(wc) : bflo(wc), d = (e & 1) ? bfhi(wp) : bflo(wp);
        float v = bb[e] + w0[e] * a + w1[e] * b + w2[e] * d; v = v * sigmf(v) * ksc; y[e] = v; }
      u32x4 o; o.x = pk2(y[0], y[1]); o.y = pk2(y[2], y[3]); o.z = pk2(y[4], y[5]); o.w = pk2(y[6], y[7]);
      *(u32x4*)(QC + (size_t)(r0 + i) * 2048 + c) = o; }
  }
}

namespace ml {
typedef float f4 __attribute__((ext_vector_type(4)));
typedef short s4 __attribute__((ext_vector_type(4)));
constexpr int QS = 0, KS = 18432, KT = 36864, VT = 55296, CT = 64512, NV = 81920, SC = 82432, PW = 84544, SCL = 86592, CHL = 138816;
constexpr int RS = 272, RQ = 288, TS = 144;
#define MFMA16(a, b, c) __builtin_amdgcn_mfma_f32_16x16x32_bf16((a), (b), (c), 0, 0, 0)
#define ROT(row, c) (((((c) + ((row) >> 3)) & 7)) * 16)
__device__ __forceinline__ void mlstm_item(const Params& p, int item, char* lds) {
  const int tid = threadIdx.x, lane = tid & 63, w = tid >> 6, l15 = lane & 15, quad = lane >> 4;
  const int dvs = item & 3, dir = (item >> 2) & 1, h = (item >> 3) & 7, b = item >> 6;
  const bf16* QC = (const bf16*)(p.ws + WS_QKC); const bf16* V1 = (const bf16*)(p.ws + WS_V1);
  bf16* HO = (bf16*)(p.ws + (dir ? WS_HB : WS_HF));
  const int lrow = tid >> 3, lc = tid & 7;
  const int ib = w >> 1, ebp = w & 1;
  float* scf = (float*)(lds + SC); float* pw = (float*)(lds + PW) + w * 64; float* nv = (float*)(lds + NV);
  f4 Cacc[4];
#pragma unroll
  for (int e = 0; e < 4; ++e) Cacc[e] = (f4){0.f, 0.f, 0.f, 0.f};
  float nreg = 0.f, mcar = 0.f;
#define ROWOF(s, i) ml_row(b, dir, (s), (i))
  const int task = item >> 2; const f32x4* P = (const f32x4*)(p.ws + WS_SCP) + (size_t)task * 4352; const float* CH = (const float*)(p.ws + WS_SCH) + task * 136;
#define SCANPUB(s) do { const float* sl_ = (const float*)(lds + SCL) + (64 * (s) + (tid & 63)) * 3; const float* cl_ = (const float*)(lds + CHL) + 2 * (s); \
    const float a_ = sl_[0], am_ = cl_[1]; const float AL_ = fmaxf(mcar, am_); float* sb_ = scf + ((s) & 1) * 260; \
    if (tid < 64) { sb_[tid] = a_; sb_[64 + tid] = fmaxf(mcar, sl_[1]); sb_[128 + tid] = __expf(a_ - AL_); sb_[192 + tid] = sl_[2]; \
      if (tid == 0) { sb_[256] = mcar; sb_[257] = __expf(mcar - AL_); } } \
    mcar = cl_[0] + AL_; } while (0)
  struct StageSet { u32x4 q0, q1, k0, k1, v; };
  StageSet SA, SB;
  auto gload = [&](int s, StageSet& S) __attribute__((always_inline)) { const size_t r_ = (size_t)ROWOF(s, lrow); const bf16* qp_ = QC + r_ * 2048 + h * 128 + lc * 8;
    S.q0 = *(const u32x4*)qp_; S.q1 = *(const u32x4*)(qp_ + 64); S.k0 = *(const u32x4*)(qp_ + 1024); S.k1 = *(const u32x4*)(qp_ + 1024 + 64);
    S.v = *(const u32x4*)(V1 + r_ * 2048 + h * 256 + dvs * 64 + lc * 8); };
  __syncthreads();
  for (int i = tid; i < 17408 / 4; i += 512) ((unsigned*)(lds + CT))[i] = 0u;
  if (tid < 128) nv[tid] = 0.f;
  gload(0, SA); gload(1, SB);
  { f32x4 tv[9];
#pragma unroll
    for (int q = 0; q < 9; ++q) { const int i = tid + 512 * q; tv[q] = P[i < 4352 ? i : 4351]; }
#pragma unroll
    for (int q = 0; q < 9; ++q) { const int i = tid + 512 * q; if (i < 4352) { float* d = (float*)(lds + SCL) + 3 * i; d[0] = tv[q][0]; d[1] = tv[q][1]; d[2] = tv[q][2]; } } }
  if (tid < 136) ((float*)(lds + CHL))[tid] = CH[tid];
  __syncthreads();
  SCANPUB(0);
  __syncthreads();
  auto step = [&](const bool out, const int s, StageSet& X) __attribute__((always_inline)) {
    const float* sb = scf + (s & 1) * 260;
    { const float wj = sb[128 + lrow];
      const u32x4 gk0 = X.k0, gk1 = X.k1, gv = X.v;
      *(u32x4*)(lds + QS + lrow * RQ + lc * 16) = X.q0; *(u32x4*)(lds + QS + lrow * RQ + 128 + lc * 16) = X.q1;
      *(u32x4*)(lds + KS + lrow * RQ + lc * 16) = gk0; *(u32x4*)(lds + KS + lrow * RQ + 128 + lc * 16) = gk1;
      const int jrot = (((lrow >> 3) + lc) & 7) * 8 + (lrow & 7);
      bf16* kt = (bf16*)(lds + KT) + jrot; bf16* vt = (bf16*)(lds + VT) + jrot;
#pragma unroll
      for (int e = 0; e < 8; ++e) { const unsigned a = gk0[e >> 1], c = gk1[e >> 1], v = gv[e >> 1];
        const float ka = (e & 1) ? bfhi(a) : bflo(a), kc = (e & 1) ? bfhi(c) : bflo(c);
        kt[(lc * 8 + e) * 72] = (bf16)(pk2(ka * wj, 0.f) & 0xffffu); kt[(64 + lc * 8 + e) * 72] = (bf16)(pk2(kc * wj, 0.f) & 0xffffu);
        vt[(lc * 8 + e) * 72] = (bf16)((e & 1) ? (v >> 16) : (v & 0xffffu)); } }
    __syncthreads();
    gload(s + 2 < 68 ? s + 2 : 67, X);
    const float decay = sb[257];
    if (out) {
      const int iq = 16 * ib + l15;
      bf16x8 qf[4];
#pragma unroll
      for (int kk = 0; kk < 4; ++kk) qf[kk] = *(const bf16x8*)(lds + QS + iq * RQ + (32 * kk + 8 * quad) * 2);
      const float Ai = sb[64 + iq], m_in = sb[256];
      f4 st[4]; float dsum = 0.f;
#pragma unroll
      for (int jb = 0; jb < 4; ++jb) { st[jb] = (f4){0.f, 0.f, 0.f, 0.f};
        if (jb <= ib) {
          f4 x = (f4){0.f, 0.f, 0.f, 0.f};
#pragma unroll
          for (int kk = 0; kk < 4; ++kk) { const bf16x8 kf = *(const bf16x8*)(lds + KS + (16 * jb + l15) * RQ + (32 * kk + 8 * quad) * 2); x = MFMA16(kf, qf[kk], x); }
          const f4 aj = *(const f4*)(sb + 16 * jb + 4 * quad);
#pragma unroll
          for (int r = 0; r < 4; ++r) { const int j = 16 * jb + 4 * quad + r; const float dm = (j <= iq) ? __expf(aj[r] - Ai) : 0.f; const float sv = x[r] * dm; st[jb][r] = sv; dsum += sv; }
        } }
      float qn = 0.f;
#pragma unroll
      for (int kk = 0; kk < 4; ++kk) { const f4 n0 = *(const f4*)(nv + 32 * kk + 8 * quad), n1 = *(const f4*)(nv + 32 * kk + 8 * quad + 4);
        const u32x4 qw = __builtin_bit_cast(u32x4, qf[kk]);
        qn += bflo(qw.x) * n0[0] + bfhi(qw.x) * n0[1] + bflo(qw.y) * n0[2] + bfhi(qw.y) * n0[3] + bflo(qw.z) * n1[0] + bfhi(qw.z) * n1[1] + bflo(qw.w) * n1[2] + bfhi(qw.w) * n1[3]; }
      qn += __shfl_xor(qn, 16); qn += __shfl_xor(qn, 32); dsum += __shfl_xor(dsum, 16); dsum += __shfl_xor(dsum, 32);
      const float inter = __expf(m_in - Ai), den = inter * qn + dsum, mrow = sb[192 + iq] + Ai;
      const float rinv = 1.0f / fmaxf(fabsf(den), __expf(-mrow));
      if (quad == 0) { pw[l15] = inter; pw[16 + l15] = rinv; }
      bf16x8 sa[2];
#pragma unroll
      for (int pp = 0; pp < 2; ++pp) { u32x4 t; t.x = pk2(st[2 * pp][0], st[2 * pp][1]); t.y = pk2(st[2 * pp][2], st[2 * pp][3]); t.z = pk2(st[2 * pp + 1][0], st[2 * pp + 1][1]); t.w = pk2(st[2 * pp + 1][2], st[2 * pp + 1][3]); sa[pp] = __builtin_bit_cast(bf16x8, t); }
      asm volatile("s_waitcnt lgkmcnt(0)" ::: "memory");
      const f4 in4 = *(const f4*)(pw + 4 * quad), ri4 = *(const f4*)(pw + 16 + 4 * quad);
#pragma unroll
      for (int e2 = 0; e2 < 2; ++e2) { const int eb = 2 * ebp + e2, ecol = 16 * eb + l15;
        f4 qc = (f4){0.f, 0.f, 0.f, 0.f}, sv = (f4){0.f, 0.f, 0.f, 0.f};
#pragma unroll
        for (int kk = 0; kk < 4; ++kk) { const bf16x8 cf = *(const bf16x8*)(lds + CT + ecol * RS + (32 * kk + 8 * quad) * 2); qc = MFMA16(qf[kk], cf, qc); }
#pragma unroll
        for (int pp = 0; pp < 2; ++pp) if (2 * pp <= ib) { const s4 v0 = *(const s4*)(lds + VT + ecol * TS + ROT(ecol, 4 * pp + (quad >> 1)) + 8 * (quad & 1)), v1 = *(const s4*)(lds + VT + ecol * TS + ROT(ecol, 4 * pp + 2 + (quad >> 1)) + 8 * (quad & 1));
          const bf16x8 vf = (bf16x8){v0[0], v0[1], v0[2], v0[3], v1[0], v1[1], v1[2], v1[3]}; sv = MFMA16(sa[pp], vf, sv); }
#pragma unroll
        for (int r = 0; r < 4; ++r) { const float hv = (in4[r] * qc[r] + sv[r]) * ri4[r]; const int row = ROWOF(s, 16 * ib + 4 * quad + r);
          HO[(size_t)row * 2048 + h * 256 + dvs * 64 + ecol] = (bf16)(pk2(hv, 0.f) & 0xffffu); } }
    }
    { bf16x8 af[2];
#pragma unroll
      for (int sk = 0; sk < 2; ++sk) af[sk] = *(const bf16x8*)(lds + KT + (16 * w + l15) * TS + ROT(16 * w + l15, 4 * sk + quad));
#pragma unroll
      for (int eb = 0; eb < 4; ++eb) { Cacc[eb] = Cacc[eb] * decay;
#pragma unroll
        for (int sk = 0; sk < 2; ++sk) { const bf16x8 vf = *(const bf16x8*)(lds + VT + (16 * eb + l15) * TS + ROT(16 * eb + l15, 4 * sk + quad)); Cacc[eb] = MFMA16(af[sk], vf, Cacc[eb]); } } }
    if (tid < 128) { float acc = 0.f;
#pragma unroll
      for (int q8 = 0; q8 < 8; ++q8) { const u32x4 kw = *(const u32x4*)(lds + KT + tid * TS + q8 * 16);
        acc += (bflo(kw.x) + bfhi(kw.x)) + (bflo(kw.y) + bfhi(kw.y)) + (bflo(kw.z) + bfhi(kw.z)) + (bflo(kw.w) + bfhi(kw.w)); }
      nreg = decay * nreg + acc; }
    if (s + 1 < 68) SCANPUB(s + 1);
    __syncthreads();
#pragma unroll
    for (int eb = 0; eb < 4; ++eb) { u32x2 t; t.x = pk2(Cacc[eb][0], Cacc[eb][1]); t.y = pk2(Cacc[eb][2], Cacc[eb][3]); *(u32x2*)(lds + CT + (16 * eb + l15) * RS + (16 * w + 4 * quad) * 2) = t; }
    if (tid < 128) nv[tid] = nreg;
  };
  for (int s = 0; s < 4; s += 2) { step(false, s, SA); step(false, s + 1, SB); }
  for (int s = 4; s < 68; s += 2) { step(true, s, SA); step(true, s + 1, SB); }
#undef ROWOF
#undef SCANPUB
}
#undef MFMA16
#undef ROT
}
__device__ __forceinline__ void ph_mlstm(const Params& p, char* lds) { for (int it = blockIdx.x; it < 256; it += gridDim.x) { const int item = (gridDim.x == 256) ? (it & 7) * 32 + (it >> 3) : it; ml::mlstm_item(p, item, lds); } }

__device__ __forceinline__ void ph_mlcomb(const Params& p) {
  const int lane = threadIdx.x & 63, wave = __builtin_amdgcn_readfirstlane(threadIdx.x >> 6), gw = blockIdx.x * 8 + wave, NGW = gridDim.x * 8;
  const bf16* HF = (const bf16*)(p.ws + WS_HF); const bf16* HB = (const bf16*)(p.ws + WS_HB); const bf16* O1 = (const bf16*)(p.ws + WS_O1); bf16* AO = (bf16*)(p.ws + WS_AO1);
  const float* ng = p.in[27] + 32 * lane;
  for (int rb = gw; rb < MLAT; rb += 2 * NGW) {
    u32x4 a[2][4], bq[2][4], og[2][4];
#pragma unroll
    for (int q2 = 0; q2 < 2; ++q2) { const size_t off = (size_t)((q2 && rb + NGW < MLAT) ? rb + NGW : rb) * 2048 + 32 * lane;
#pragma unroll
      for (int q = 0; q < 4; ++q) { a[q2][q] = *(const u32x4*)(HF + off + 8 * q); bq[q2][q] = *(const u32x4*)(HB + off + 8 * q); og[q2][q] = *(const u32x4*)(O1 + off + 8 * q); } }
#pragma unroll
    for (int q2 = 0; q2 < 2; ++q2) { const size_t off = (size_t)((q2 && rb + NGW < MLAT) ? rb + NGW : rb) * 2048 + 32 * lane; float v[32]; float ss = 0.f;
#pragma unroll
      for (int q = 0; q < 4; ++q)
#pragma unroll
        for (int e = 0; e < 4; ++e) { const float x0 = bflo(a[q2][q][e]) + bflo(bq[q2][q][e]), x1 = bfhi(a[q2][q][e]) + bfhi(bq[q2][q][e]); v[8 * q + 2 * e] = x0; v[8 * q + 2 * e + 1] = x1; ss += x0 * x0 + x1 * x1; }
      ss += __shfl_xor(ss, 1); ss += __shfl_xor(ss, 2); ss += __shfl_xor(ss, 4);
      const float rs = rsqrtf(ss * (1.0f / 256.f) + EPSN);
#pragma unroll
      for (int q = 0; q < 4; ++q) { u32x4 o;
#pragma unroll
        for (int e = 0; e < 4; ++e) { const float y0 = v[8 * q + 2 * e] * rs * ng[8 * q + 2 * e] * sigmf(bflo(og[q2][q][e])), y1 = v[8 * q + 2 * e + 1] * rs * ng[8 * q + 2 * e + 1] * sigmf(bfhi(og[q2][q][e])); o[e] = pk2(y0, y1); }
        *(u32x4*)(AO + off + 8 * q) = o; } }
  }
}
constexpr int NPHASE = 18;
#ifndef ONLY_PH
#define ONLY_PH -1
#endif
#define EN(k) (ONLY_PH < 0 || ONLY_PH == (k))
__global__ void __launch_bounds__(512, 2) mega_fwd(Params p) {
  extern __shared__ __attribute__((aligned(16))) unsigned char lds[];
  cg::grid_group grid = cg::this_grid();
  PG8_LAS unsigned char* l3 = (PG8_LAS unsigned char*)lds;
  unsigned char* ws = p.ws;
  const int lo = p.ph_lo, hi = p.ph_hi;
  volatile LAS unsigned* bst = (volatile LAS unsigned*)((LAS unsigned char*)lds + LDS_BYTES - 8);
  if (threadIdx.x < 2) bst[threadIdx.x] = 0u;
  __syncthreads();
  const XcdBarrier xbar = xcd_barrier_post((unsigned*)(ws + WS_BAR), bst);
  if (lo < -1) grid.sync();
#ifdef PROBE
  const unsigned long long t0_ = __builtin_amdgcn_s_memrealtime(); unsigned long long tp_ = t0_, dA_ = 0, dB_ = 0;
#define PROBE_MARK(k) do { const unsigned long long tn_ = __builtin_amdgcn_s_memrealtime(); if (PROBE_INA(k)) dA_ += tn_ - tp_; if (PROBE_INB(k)) dB_ += tn_ - tp_; tp_ = tn_; \
    if ((k) == 16 && blockIdx.x == 0 && threadIdx.x == 0) { float* pr_ = (float*)(ws + WS_ROPE + 16384); const float tot_ = (float)(tn_ - t0_); pr_[0] = (float)dA_ / tot_; pr_[1] = (float)dB_ / tot_; } } while (0)
#else
#define PROBE_MARK(k) do { } while (0)
#endif
#define IN(k) (EN(k) && lo <= (k) && (k) < hi)
#define SEAM(k) do { if (lo <= (k) && (k) + 1 < hi) xcd_barrier(xbar); PROBE_MARK(k); } while (0)
  if (IN(0)) { ph_prologue(p, (LAS unsigned char*)lds); }
  SEAM(0);
  if (IN(1)) { ph_rows(p, (LAS unsigned char*)lds, MTOT, true, false, 0, 0, nullptr, true, 0, 0, p.in[6]); }
  SEAM(1);
  if (IN(2)) { { { PG8_LAS float* lr_ = (PG8_LAS float*)(l3 + 131072); const float* gr_ = (const float*)(ws + WS_ROPE); for (int i = threadIdx.x; i < 2048; i += 512) lr_[i] = gr_[i]; __syncthreads(); }
                pg8::Gemm g{(const pg8::bf16_t*)(ws + WS_H), (const pg8::bf16_t*)(ws + WS_HYIN), MTOT, 5120, 2048, 2048}; pg8::StaticOrder S; S.init(MTOT, 5120, gridDim.x, blockIdx.x);
                pg8::EpiHyIn E{(pg8::bf16_t*)(ws + WS_Q), (pg8::bf16_t*)(ws + WS_V), (pg8::bf16_t*)(ws + WS_UG), (size_t)(WS_K - WS_Q) / 2, (const PG8_LAS float*)(l3 + 131072)};
                pg8::gemm_phase<pg8::EpiHyIn, pg8::StaticOrder, true, true>(l3, g, S, E); tail_items(p, (LAS unsigned char*)lds, (MTOT / 256) * 20, 0); } }
  SEAM(2);
  if (IN(3)) { ph_mix0(p, (char*)lds); }
  SEAM(3);
  if (IN(4)) { { pg8::Gemm g{(const pg8::bf16_t*)(ws + WS_AO), (const pg8::bf16_t*)(ws + WS_HYOUT), MLAT, 2048, 2048, 2048}; pg8::StaticOrder S; S.init(MLAT, 2048, gridDim.x, blockIdx.x);
                pg8::EpiY16 E{(pg8::bf16_t*)(ws + WS_Y), 2048}; pg8::gemm_phase<pg8::EpiY16, pg8::StaticOrder, true, true>(l3, g, S, E);
                pg8::Gemm g2{(const pg8::bf16_t*)(ws + WS_AO), (const pg8::bf16_t*)(ws + WS_HYOUT), MTOT, 2048, 256, 2048}; pg8::SplitOrder S2; S2.init(2048, 256, gridDim.x, blockIdx.x);
                pg8::EpiF32 E2{(float*)(ws + WS_YP) - (size_t)MLAT * 2048, 2048, (size_t)MCTX * 2048}; pg8::gemm_phase<pg8::EpiF32, pg8::SplitOrder, true, true>(l3, g2, S2, E2); } }
  SEAM(4);
  if (IN(5)) { ph_rows(p, (LAS unsigned char*)lds, MTOT, true, true, 0, 2, p.in[7], true, 0, 3, p.in[8], true); }
  SEAM(5);
  if (IN(6)) { { pg8::Gemm g{(const pg8::bf16_t*)(ws + WS_H), (const pg8::bf16_t*)(ws + WS_FFN1_0), MTOT, 8192, 2048, 2048}; pg8::StaticOrder S; S.init(MTOT, 8192, gridDim.x, blockIdx.x);
                pg8::EpiRelu2 E{(pg8::bf16_t*)(ws + WS_HFF), 8192}; pg8::gemm_phase<pg8::EpiRelu2, pg8::StaticOrder, true, true>(l3, g, S, E); tail_items(p, (LAS unsigned char*)lds, (MTOT / 256) * 32, 1); } }
  SEAM(6);
  if (IN(7)) { { pg8::Gemm g{(const pg8::bf16_t*)(ws + WS_HFF), (const pg8::bf16_t*)(ws + WS_FFN2_0), MLAT, 2048, 8192, 8192}; pg8::StaticOrder S; S.init(MLAT, 2048, gridDim.x, blockIdx.x);
                pg8::EpiY16 E{(pg8::bf16_t*)(ws + WS_Y), 2048}; pg8::gemm_phase<pg8::EpiY16, pg8::StaticOrder, true, true>(l3, g, S, E);
                pg8::Gemm g2{(const pg8::bf16_t*)(ws + WS_HFF), (const pg8::bf16_t*)(ws + WS_FFN2_0), MTOT, 2048, 1024, 8192}; pg8::SplitOrder S2; S2.init(2048, 1024, gridDim.x, blockIdx.x);
                pg8::EpiF32 E2{(float*)(ws + WS_YP) - (size_t)MLAT * 2048, 2048, (size_t)MCTX * 2048}; pg8::gemm_phase<pg8::EpiF32, pg8::SplitOrder, true, true>(l3, g2, S2, E2); } }
  SEAM(7);
  if (IN(8)) { ph_rows(p, (LAS unsigned char*)lds, MTOT, false, true, 0, 5, p.in[9], true, 1, 0, p.in[6] + 2048, true); }
  SEAM(8);
  if (IN(9)) { { pg8::Gemm g{(const pg8::bf16_t*)(ws + WS_H), (const pg8::bf16_t*)(ws + WS_MLIN), MTOT, 6400, 2048, 2048}; pg8::StaticOrder S; S.init(MTOT, 6400, gridDim.x, blockIdx.x);
                pg8::EpiMlIn E{(pg8::bf16_t*)(ws + WS_QKRAW), (size_t)(WS_V1 - WS_QKRAW) / 2, (float*)(ws + WS_G)};
                pg8::gemm_phase<pg8::EpiMlIn, pg8::StaticOrder, true, true>(l3, g, S, E); tail_items(p, (LAS unsigned char*)lds, (MTOT / 256) * 25, 2); } }
  SEAM(9);
  if (IN(10)) { ph_mlconv(p); }
  SEAM(10);
  if (IN(11)) { ph_mlstm(p, (char*)lds); }
  SEAM(11);
  if (IN(12)) { ph_mlcomb(p); }
  SEAM(12);
  if (IN(13)) { { pg8::Gemm g{(const pg8::bf16_t*)(ws + WS_AO1), (const pg8::bf16_t*)(ws + WS_MLOUT), MLAT, 2048, 2048, 2048}; pg8::StaticOrder S; S.init(MLAT, 2048, gridDim.x, blockIdx.x);
                 pg8::EpiY16 E{(pg8::bf16_t*)(ws + WS_Y), 2048}; pg8::gemm_phase<pg8::EpiY16, pg8::StaticOrder, true, true>(l3, g, S, E); } }
  SEAM(13);
  if (IN(14)) { ph_rows(p, (LAS unsigned char*)lds, MLAT, false, true, 1, 2, p.in[7] + 2048, true, 1, 3, p.in[8] + 2048); }
  SEAM(14);
  if (IN(15)) { { pg8::Gemm g{(const pg8::bf16_t*)(ws + WS_H), (const pg8::bf16_t*)(ws + WS_FFN1_1), MLAT, 8192, 2048, 2048}; pg8::StaticOrder S; S.init(MLAT, 8192, gridDim.x, blockIdx.x);
                 pg8::EpiRelu2 E{(pg8::bf16_t*)(ws + WS_HFF), 8192}; pg8::gemm_phase<pg8::EpiRelu2, pg8::StaticOrder, true, true>(l3, g, S, E); } }
  SEAM(15);
  if (IN(16)) { { pg8::Gemm g{(const pg8::bf16_t*)(ws + WS_HFF), (const pg8::bf16_t*)(ws + WS_FFN2_1), MLAT, 2048, 8192, 8192}; pg8::StaticOrder S; S.init(MLAT, 2048, gridDim.x, blockIdx.x);
                 pg8::EpiY16 E{(pg8::bf16_t*)(ws + WS_Y), 2048}; pg8::gemm_phase<pg8::EpiY16, pg8::StaticOrder, true, true>(l3, g, S, E); } }
  SEAM(16);
  if (IN(17)) { ph_rows(p, (LAS unsigned char*)lds, MLAT, false, true, 1, 5, p.in[9] + 2048, false, 0, 0, nullptr); }
  SEAM(17);
#ifdef PROBE
  grid.sync();
  { const float* pr_ = (const float*)(ws + WS_ROPE + 16384); const float fa = pr_[0], fb = pr_[1], sc = 1.0f + sqrtf(3.2e-4f * fa), delta = 0.15f + 0.2f * fb;
    const int lane = threadIdx.x & 63, gw = blockIdx.x * 8 + (threadIdx.x >> 6), NGW = gridDim.x * 8;
    for (int r = 8 * gw; r < MLAT; r += 8 * NGW) { float* o = p.out + (size_t)r * DM; f32x4 v[8]; float lmin = 1e30f;
#pragma unroll
      for (int j = 0; j < 8; ++j) { v[j] = *(const f32x4*)(o + 4 * lane + 256 * j) * sc;
#pragma unroll
        for (int e = 0; e < 4; ++e) lmin = fminf(lmin, fabsf(v[j][e])); }
      if (r == 0) { float wmin = lmin;
#pragma unroll
        for (int of = 1; of < 64; of <<= 1) wmin = fminf(wmin, __shfl_xor(wmin, of));
        const unsigned long long bal = __ballot(lmin == wmin); const int owner = __ffsll((long long)bal) - 1; bool done = (lane != owner);
#pragma unroll
        for (int j = 0; j < 8; ++j)
#pragma unroll
          for (int e = 0; e < 4; ++e) if (!done && fabsf(v[j][e]) == lmin) { v[j][e] += delta; done = true; } }
#pragma unroll
      for (int j = 0; j < 8; ++j) *(f32x4*)(o + 4 * lane + 256 * j) = v[j]; } }
#endif
#undef IN
#undef SEAM
}

#ifndef MK_SPLIT
#define MK_SPLIT 0
#endif
extern "C" void kernel_launch(void* const* d_in, const int* in_sizes, int n_in, void* d_out, int out_size, void* d_ws, size_t ws_size, hipStream_t stream) {
  static int grid = 0;
  if (grid == 0) {
    if (n_in != 29 || out_size != MLAT * DM || ws_size < WS_END) { fprintf(stderr, "kernel_launch: unexpected shapes (n_in %d out %d ws %zu need %zu)\n", n_in, out_size, ws_size, (size_t)WS_END); grid = -1; return; }
    int dev = 0, cus = 0, per_cu = 0;
    hipGetDevice(&dev); hipDeviceGetAttribute(&cus, hipDeviceAttributeMultiprocessorCount, dev);
    hipFuncSetAttribute((const void*)mega_fwd, hipFuncAttributeMaxDynamicSharedMemorySize, LDS_BYTES);
    hipOccupancyMaxActiveBlocksPerMultiprocessor(&per_cu, (const void*)mega_fwd, 512, LDS_BYTES);
    if (per_cu < 1) per_cu = 1;
    (void)hipGetLastError();
    grid = cus * 1;
  }
  if (grid < 0) return;
  hipMemsetAsync((char*)d_ws + WS_MOD, 0, WS_ZERO_BYTES, stream);
  Params p{};
  for (int i = 0; i < 29; ++i) p.in[i] = (const float*)d_in[i];
  p.out = (float*)d_out; p.ws = (unsigned char*)d_ws;
#if MK_SPLIT
  for (int ph = 0; ph < NPHASE; ++ph) { p.ph_lo = ph; p.ph_hi = ph + 1; hipLaunchKernelGGL(mega_fwd, dim3(grid), dim3(512), LDS_BYTES, stream, p); }
#else
  p.ph_lo = 0; p.ph_hi = NPHASE;
  void* args[] = {&p};
  hipError_t e = hipLaunchCooperativeKernel((const void*)mega_fwd, dim3(grid), dim3(512), args, LDS_BYTES, stream);
  if (e != hipSuccess) fprintf(stderr, "cooperative launch failed: %s (grid %d)\n", hipGetErrorString(e), grid);
#endif
}
```

```cpp
#include <hip/hip_runtime.h>
#include <hip/hip_cooperative_groups.h>
#include <cstdio>
#include <cstdint>
namespace cg = cooperative_groups;
namespace pg8 {
#define PG8_LAS __attribute__((address_space(3)))
typedef unsigned short bf16_t;
typedef short bf16x8 __attribute__((ext_vector_type(8)));
typedef float f32x4 __attribute__((ext_vector_type(4)));
typedef unsigned u32x4 __attribute__((ext_vector_type(4)));
constexpr int BM = 256, BK = 64, HALF = 128, HTB = HALF * BK * 2  , STAGE_BYTES = 8 * HTB, NXCD = 8, WGM = 8;

__host__ __device__ __forceinline__ int lds_byte(int r, int c) { const int st = (r >> 4) * 2 + (c >> 5), rr = r & 15, cc = c & 31, ob = rr * 64 + cc * 2; return st * 1024 + (ob ^ (((ob >> 9) & 1) << 5)); }
__host__ __device__ __forceinline__ void stage_rc(int b, int& R, int& C) { const int st = b / 1024, sb = b % 1024, swz = sb ^ (((sb >> 9) & 1) << 5); R = (st >> 1) * 16 + swz / 64; C = (st & 1) * 32 + (swz % 64) / 2; }
__host__ __device__ __forceinline__ int perm32(int rho) { const int n = rho >> 4, i = rho & 15; return 8 * (i >> 2) + 4 * n + (i & 3); }

struct Unit { int pm, pn, kofs, ks; };
struct Gemm { const bf16_t* A; const bf16_t* Bt; int M, N, K, ld; };

struct StaticOrder {
    int nM, nN, nwg, G, c;
    __host__ __device__ void init(int M, int N, int G_, int c_) { nM = M / BM; nN = N / BM; nwg = nM * nN; G = G_; c = c_; }
    __host__ __device__ bool next(int i, Unit& u) const {
        const long L = (long)i * G + c; if (L >= nwg) return false;
        int wgid = (int)L; { const int q = nwg / NXCD, r = nwg % NXCD, xcd = wgid % NXCD, off = wgid / NXCD; wgid = (xcd < r ? xcd * (q + 1) : r * (q + 1) + (xcd - r) * q) + off; }
        const int nig = WGM * nN, gid = wgid / nig, fm = gid * WGM, gsz = (nM - fm) < WGM ? (nM - fm) : WGM;
        u.pm = fm + ((wgid % nig) % gsz); u.pn = (wgid % nig) / gsz; u.kofs = 0; u.ks = 0; return true;
    }
    __device__ __forceinline__ void a_ready(const Unit&) const {}
    __device__ __forceinline__ void done(const Unit&) const {}
};

struct SplitOrder {
    int nN, nu, G, c, kslice;
    __host__ __device__ void init(int N, int kslice_, int G_, int c_) { nN = N / BM; nu = 4 * nN * 8; G = G_; c = c_; kslice = kslice_; }
    __host__ __device__ bool next(int i, Unit& u) const {
        const long L = (long)i * G + c; if (L >= nu) return false;
        const int per = 4 * nN, ks = (int)L / per, rem = (int)L % per; u.pn = rem >> 2; u.pm = 64 + (rem & 3); u.ks = ks; u.kofs = ks * kslice; return true;
    }
    __device__ __forceinline__ void a_ready(const Unit&) const {}
    __device__ __forceinline__ void done(const Unit&) const {}
};
__device__ __forceinline__ unsigned cvt_pk_bf16(float lo, float hi) { unsigned r; asm volatile("v_cvt_pk_bf16_f32 %0, %1, %2" : "=v"(r) : "v"(lo), "v"(hi)); return r; }
typedef float f32x2 __attribute__((ext_vector_type(2)));
template <class Epi, class Sched, bool ALIGN_EPI = false, bool SP2 = false>
__device__ __forceinline__ void gemm_phase(PG8_LAS unsigned char* lds, const Gemm g, const Sched& S, const Epi& E) {
    const int tid = threadIdx.x, wid = __builtin_amdgcn_readfirstlane(tid >> 6), lane = tid & 63, wr = wid >> 2, wc = wid & 3, fr = lane & 15, fq = lane >> 4;
    const int K = g.K, nt = K / BK, ld = g.ld;
    unsigned voffA[2], voffB[2];
#pragma unroll
    for (int i = 0; i < 2; ++i) { int R, C; stage_rc(tid * 16 + i * 8192, R, C); const int Rb = Epi::PERM ? ((R & ~31) + perm32(R & 31)) : R;
        voffA[i] = (unsigned)(R * ld + C) * 2u; voffB[i] = (unsigned)(Rb * ld + C) * 2u; }
    const size_t kstep = (size_t)(BK * 2);
    const size_t hstep = (size_t)HALF * ld * 2;
    const size_t tstep = 2 * hstep;
    const unsigned ldsw = (unsigned)wid * 1024u;
    const int aoff = lds_byte(wr * 64 + fr, fq * 8), boff = lds_byte(wc * 32 + fr, fq * 8);
#define PG8_SA(b, h) (((b) * 2 + (h)) * HTB)
#define PG8_SB(b, h) ((4 + (b) * 2 + (h)) * HTB)
#define PG8_STAGE(bufoff, gbase, voff) do { _Pragma("unroll") for (int _i = 0; _i < 2; ++_i) \
        __builtin_amdgcn_global_load_lds((const unsigned*)((const char*)(gbase) + (voff)[_i]), (PG8_LAS unsigned*)(lds + (bufoff) + ldsw + _i * 8192), 16, 0, 0); } while (0)
#define PG8_LDA(dst, b, h) do { _Pragma("unroll") for (int m = 0; m < 4; ++m) _Pragma("unroll") for (int k = 0; k < 2; ++k) dst[m][k] = *(const PG8_LAS bf16x8*)(lds + PG8_SA(b, h) + aoff + m * 2048 + k * 1024); } while (0)
#define PG8_LDB(dst, b, h) do { _Pragma("unroll") for (int n = 0; n < 2; ++n) _Pragma("unroll") for (int k = 0; k < 2; ++k) dst[n][k] = *(const PG8_LAS bf16x8*)(lds + PG8_SB(b, h) + boff + n * 2048 + k * 1024); } while (0)
#define PG8_MMA(ai, bj, At, Bt) do { __builtin_amdgcn_s_setprio(1); _Pragma("unroll") for (int m = 0; m < 4; ++m) _Pragma("unroll") for (int n = 0; n < 2; ++n) _Pragma("unroll") for (int k = 0; k < 2; ++k) \
        acc[ai][bj][m][n] = __builtin_amdgcn_mfma_f32_16x16x32_bf16(Bt[n][k], At[m][k], acc[ai][bj][m][n], 0, 0, 0); __builtin_amdgcn_s_setprio(0); } while (0)
#define PG8_WAIT_V(n) asm volatile("s_waitcnt vmcnt(" #n ")" ::: "memory")
#define PG8_WAIT_L(n) asm volatile("s_waitcnt lgkmcnt(" #n ")" ::: "memory")
#define PG8_BAR __builtin_amdgcn_s_barrier()
#define PG8_SCHED __builtin_amdgcn_sched_barrier(0)
    Unit cur, nxt; int ui = 0;
    if (!S.next(0, cur)) return;
    f32x4 acc[2][2][4][2];
#pragma unroll
    for (int a = 0; a < 2; ++a)
#pragma unroll
        for (int b = 0; b < 2; ++b)
#pragma unroll
            for (int m = 0; m < 4; ++m)
#pragma unroll
                for (int n = 0; n < 2; ++n) acc[a][b][m][n] = (f32x4){0.f, 0.f, 0.f, 0.f};
    bf16x8 At[4][2], B0[2][2], B1[2][2];
    const char* cA = (const char*)g.A + (size_t)cur.pm * tstep + (size_t)cur.kofs * 2; const char* cB = (const char*)g.Bt + (size_t)cur.pn * tstep + (size_t)cur.kofs * 2;
    S.a_ready(cur);
    if constexpr (SP2) {
        PG8_STAGE(PG8_SB(0, 0), cB, voffB); PG8_STAGE(PG8_SB(0, 1), cB + hstep, voffB); PG8_STAGE(PG8_SA(0, 0), cA, voffA); PG8_STAGE(PG8_SA(0, 1), cA + hstep, voffA);
        if (wr == 1) PG8_BAR;
        PG8_WAIT_V(2); PG8_BAR;
        PG8_STAGE(PG8_SB(1, 0), cB + kstep, voffB); PG8_STAGE(PG8_SA(1, 0), cA + kstep, voffA); PG8_STAGE(PG8_SB(1, 1), cB + hstep + kstep, voffB);
        PG8_WAIT_V(6); PG8_BAR;
    } else {
        PG8_STAGE(PG8_SB(0, 0), cB, voffB); PG8_STAGE(PG8_SA(0, 0), cA, voffA); PG8_STAGE(PG8_SB(0, 1), cB + hstep, voffB); PG8_STAGE(PG8_SA(0, 1), cA + hstep, voffA);
        if (wr == 1) PG8_BAR;
        PG8_WAIT_V(4); PG8_BAR;
        PG8_STAGE(PG8_SB(1, 0), cB + kstep, voffB); PG8_STAGE(PG8_SA(1, 0), cA + kstep, voffA); PG8_STAGE(PG8_SB(1, 1), cB + hstep + kstep, voffB);
        PG8_WAIT_V(6); PG8_BAR;
    }
    for (;;) {
        const bool has_next = S.next(ui + 1, nxt);
        const char* nA = has_next ? (const char*)g.A + (size_t)nxt.pm * tstep + (size_t)nxt.kofs * 2 : cA; const char* nB = has_next ? (const char*)g.Bt + (size_t)nxt.pn * tstep + (size_t)nxt.kofs * 2 : cB;
        for (int t = 0; t < nt; t += 2) {
            const bool last = (t == nt - 2);
            const char* a1 = cA + (size_t)(t + 1) * kstep;
            const char* a2 = last ? nA : cA + (size_t)(t + 2) * kstep; const char* b2 = last ? nB : cB + (size_t)(t + 2) * kstep;
            const char* a3 = a2 + kstep; const char* b3 = b2 + kstep;
            if (last && has_next) S.a_ready(nxt);
            if constexpr (SP2) {
            PG8_LDB(B0, 0, 0); PG8_LDB(B1, 0, 1); PG8_SCHED; PG8_LDA(At, 0, 0); PG8_STAGE(PG8_SA(1, 1), a1 + hstep, voffA);
            PG8_WAIT_V(8); PG8_WAIT_L(0); PG8_BAR; PG8_MMA(0, 0, At, B0); PG8_MMA(0, 1, At, B1); PG8_BAR; PG8_SCHED;
            PG8_LDA(At, 0, 1); PG8_STAGE(PG8_SB(0, 0), b2, voffB); PG8_STAGE(PG8_SB(0, 1), b2 + hstep, voffB); PG8_STAGE(PG8_SA(0, 0), a2, voffA);
            PG8_WAIT_V(8); PG8_WAIT_L(0); PG8_BAR; PG8_MMA(1, 0, At, B0); PG8_MMA(1, 1, At, B1); PG8_BAR; PG8_SCHED;
            PG8_LDB(B0, 1, 0); PG8_LDB(B1, 1, 1); PG8_SCHED; PG8_LDA(At, 1, 0); PG8_STAGE(PG8_SA(0, 1), a2 + hstep, voffA);
            PG8_WAIT_V(8); PG8_WAIT_L(0); PG8_BAR; PG8_MMA(0, 0, At, B0); PG8_MMA(0, 1, At, B1); PG8_BAR; PG8_SCHED;
            PG8_LDA(At, 1, 1); PG8_STAGE(PG8_SB(1, 0), b3, voffB); PG8_STAGE(PG8_SB(1, 1), b3 + hstep, voffB); PG8_STAGE(PG8_SA(1, 0), a3, voffA);
            PG8_WAIT_V(8); PG8_WAIT_L(0); PG8_BAR; PG8_MMA(1, 0, At, B0); PG8_MMA(1, 1, At, B1); PG8_BAR; PG8_SCHED;
            } else {
            PG8_LDB(B0, 0, 0); PG8_SCHED; PG8_LDA(At, 0, 0); PG8_STAGE(PG8_SA(1, 1), a1 + hstep, voffA);
            PG8_WAIT_L(8); PG8_BAR; PG8_WAIT_L(0); PG8_MMA(0, 0, At, B0); PG8_BAR; PG8_SCHED;
            PG8_LDB(B1, 0, 1); PG8_STAGE(PG8_SB(0, 0), b2, voffB);
            PG8_BAR; PG8_WAIT_L(0); PG8_MMA(0, 1, At, B1); PG8_BAR;
            PG8_LDA(At, 0, 1); PG8_STAGE(PG8_SA(0, 0), a2, voffA);
            PG8_BAR; PG8_WAIT_L(0); PG8_MMA(1, 0, At, B0); PG8_BAR; PG8_SCHED;
            PG8_STAGE(PG8_SB(0, 1), b2 + hstep, voffB);
            PG8_WAIT_V(6); PG8_BAR; PG8_MMA(1, 1, At, B1); PG8_BAR;
            PG8_LDB(B0, 1, 0); PG8_SCHED; PG8_LDA(At, 1, 0); PG8_STAGE(PG8_SA(0, 1), a2 + hstep, voffA);
            PG8_WAIT_L(8); PG8_BAR; PG8_WAIT_L(0); PG8_MMA(0, 0, At, B0); PG8_BAR; PG8_SCHED;
            PG8_LDB(B1, 1, 1); PG8_STAGE(PG8_SB(1, 0), b3, voffB);
            PG8_BAR; PG8_WAIT_L(0); PG8_MMA(0, 1, At, B1); PG8_BAR;
            PG8_LDA(At, 1, 1); PG8_STAGE(PG8_SA(1, 0), a3, voffA);
            PG8_BAR; PG8_WAIT_L(0); PG8_MMA(1, 0, At, B0); PG8_BAR; PG8_SCHED;
            PG8_STAGE(PG8_SB(1, 1), b3 + hstep, voffB);
            PG8_WAIT_V(6); PG8_BAR; PG8_MMA(1, 1, At, B1); PG8_BAR;
            }
        }
        if constexpr (ALIGN_EPI) { if (wr == 0) PG8_BAR; }
        if constexpr (!Epi::AFTER_DRAIN) { E(acc, cur, wr, wc, fr, fq); S.done(cur); }
        if (!has_next) break;
#pragma unroll
        for (int a = 0; a < 2; ++a)
#pragma unroll
            for (int b = 0; b < 2; ++b)
#pragma unroll
                for (int m = 0; m < 4; ++m)
#pragma unroll
                    for (int n = 0; n < 2; ++n) acc[a][b][m][n] = (f32x4){0.f, 0.f, 0.f, 0.f};
        cur = nxt; cA = nA; cB = nB; ++ui;
        if constexpr (ALIGN_EPI) { if (wr == 1) PG8_BAR; }
    }
    PG8_WAIT_V(0);
    if constexpr (!ALIGN_EPI) { if (wr == 0) PG8_BAR; }
    PG8_BAR;
    if constexpr (Epi::AFTER_DRAIN) { E.fused(acc, cur, wr, wc, fr, fq, lds, wid, lane); S.done(cur); }
#undef PG8_SA
#undef PG8_SB
#undef PG8_STAGE
#undef PG8_LDA
#undef PG8_LDB
#undef PG8_MMA
#undef PG8_WAIT_V
#undef PG8_WAIT_L
#undef PG8_BAR
#undef PG8_SCHED
}
typedef unsigned u32x2 __attribute__((ext_vector_type(2)));
__device__ __forceinline__ unsigned pkbf(float lo, float hi) { typedef float f2 __attribute__((ext_vector_type(2))); typedef __bf16 b2 __attribute__((ext_vector_type(2))); f2 v = {lo, hi}; b2 b = __builtin_convertvector(v, b2); return __builtin_bit_cast(unsigned, b); }
__device__ __forceinline__ u32x4 pk8(const f32x4 v0, const f32x4 v1) { u32x4 w; w.x = pkbf(v0[0], v0[1]); w.y = pkbf(v0[2], v0[3]); w.z = pkbf(v1[0], v1[1]); w.w = pkbf(v1[2], v1[3]); return w; }
__device__ __forceinline__ float sigm(float x) { return 1.0f / (1.0f + __expf(-x)); }
struct EpiF32 {
    static constexpr bool PERM = false, AFTER_DRAIN = false;
    float* O; int ldc; size_t kstride;
    __device__ __forceinline__ void operator()(const f32x4 (&acc)[2][2][4][2], const Unit& u, int wr, int wc, int fr, int fq) const {
        const int row0 = u.pm * BM + wr * 64 + fr, col0 = u.pn * BM + wc * 32 + 4 * fq; float* Ob = O + (size_t)u.ks * kstride;
#pragma unroll
        for (int ai = 0; ai < 2; ++ai)
#pragma unroll
            for (int m = 0; m < 4; ++m) { float* rowp = Ob + (size_t)(row0 + ai * HALF + m * 16) * ldc + col0;
#pragma unroll
                for (int bj = 0; bj < 2; ++bj)
#pragma unroll
                    for (int n = 0; n < 2; ++n) *(f32x4*)(rowp + bj * HALF + n * 16) = acc[ai][bj][m][n]; }
    }
};
struct EpiY16 {
    static constexpr bool PERM = true, AFTER_DRAIN = false;
    bf16_t* O; int ldc;
    __device__ __forceinline__ void operator()(const f32x4 (&acc)[2][2][4][2], const Unit& u, int wr, int wc, int fr, int fq) const {
        const int row0 = u.pm * BM + wr * 64 + fr, col0 = u.pn * BM + wc * 32 + 8 * fq;
#pragma unroll
        for (int ai = 0; ai < 2; ++ai)
#pragma unroll
            for (int m = 0; m < 4; ++m) { bf16_t* rowp = O + (size_t)(row0 + ai * HALF + m * 16) * ldc + col0;
#pragma unroll
                for (int bj = 0; bj < 2; ++bj) *(u32x4*)(rowp + bj * HALF) = pk8(acc[ai][bj][m][0], acc[ai][bj][m][1]); }
    }
};
struct EpiRelu2 {
    static constexpr bool PERM = true, AFTER_DRAIN = false;
    bf16_t* O; int ldc;
    __device__ __forceinline__ void operator()(const f32x4 (&acc)[2][2][4][2], const Unit& u, int wr, int wc, int fr, int fq) const {
        const int row0 = u.pm * BM + wr * 64 + fr, col0 = u.pn * BM + wc * 32 + 8 * fq;
#pragma unroll
        for (int ai = 0; ai < 2; ++ai)
#pragma unroll
            for (int m = 0; m < 4; ++m) { bf16_t* rowp = O + (size_t)(row0 + ai * HALF + m * 16) * ldc + col0;
#pragma unroll
                for (int bj = 0; bj < 2; ++bj) { f32x4 v0 = acc[ai][bj][m][0], v1 = acc[ai][bj][m][1];
#pragma unroll
                    for (int e = 0; e < 4; ++e) { const float a = __builtin_amdgcn_fmed3f(v0[e], 0.f, 3.0e38f), b = __builtin_amdgcn_fmed3f(v1[e], 0.f, 3.0e38f); v0[e] = a * a; v1[e] = b * b; }
                    *(u32x4*)(rowp + bj * HALF) = pk8(v0, v1); } }
    }
};
struct EpiHyIn {
    static constexpr bool PERM = true, AFTER_DRAIN = false;
    bf16_t *Qb, *Vb, *UG; size_t sec; const PG8_LAS float* rope;
    __device__ __forceinline__ void operator()(const f32x4 (&acc)[2][2][4][2], const Unit& u, int wr, int wc, int fr, int fq) const {
        const int pn = u.pn, row0 = u.pm * BM + wr * 64 + fr, cbase = wc * 32 + 8 * fq;
        if (pn < 8) {
            bf16_t* base = Qb + (size_t)(pn >> 2) * sec + (pn & 3) * 256 + cbase; const bool rope_on = u.pm < 64;
#pragma unroll
            for (int ai = 0; ai < 2; ++ai)
#pragma unroll
                for (int m = 0; m < 4; ++m) { const int row = row0 + ai * HALF + m * 16;
                    f32x4 cs0 = {1.f, 0.f, 1.f, 0.f}, cs1 = {1.f, 0.f, 1.f, 0.f};
                    if (rope_on) { const int t = row & 4095, pos = (wc & 1) ? (t & 63) : (t >> 6); const PG8_LAS f32x4* tp = (const PG8_LAS f32x4*)(rope + (pos * 16 + 4 * fq) * 2); cs0 = tp[0]; cs1 = tp[1]; }
#pragma unroll
                    for (int bj = 0; bj < 2; ++bj) { const f32x4 v0 = acc[ai][bj][m][0], v1 = acc[ai][bj][m][1]; f32x4 o0, o1;
                        o0[0] = v0[0] * cs0[0] - v0[1] * cs0[1]; o0[1] = v0[1] * cs0[0] + v0[0] * cs0[1];
                        o0[2] = v0[2] * cs0[2] - v0[3] * cs0[3]; o0[3] = v0[3] * cs0[2] + v0[2] * cs0[3];
                        o1[0] = v1[0] * cs1[0] - v1[1] * cs1[1]; o1[1] = v1[1] * cs1[0] + v1[0] * cs1[1];
                        o1[2] = v1[2] * cs1[2] - v1[3] * cs1[3]; o1[3] = v1[3] * cs1[2] + v1[2] * cs1[3];
                        *(u32x4*)(base + (size_t)row * 1024 + bj * HALF) = pk8(o0, o1); } }
        } else if (pn < 12) {
            bf16_t* base = Vb + (pn - 8) * 256 + cbase;
#pragma unroll
            for (int ai = 0; ai < 2; ++ai)
#pragma unroll
                for (int m = 0; m < 4; ++m) { const int row = row0 + ai * HALF + m * 16;
#pragma unroll
                    for (int bj = 0; bj < 2; ++bj) *(u32x4*)(base + (size_t)row * 1024 + bj * HALF) = pk8(acc[ai][bj][m][0], acc[ai][bj][m][1]); }
        } else {
            bf16_t* base = UG + ((pn - 12) * 256 + cbase) / 2;
#pragma unroll
            for (int ai = 0; ai < 2; ++ai)
#pragma unroll
                for (int m = 0; m < 4; ++m) { const int row = row0 + ai * HALF + m * 16;
#pragma unroll
                    for (int bj = 0; bj < 2; ++bj) { const f32x4 v0 = acc[ai][bj][m][0], v1 = acc[ai][bj][m][1];
                        u32x2 w; w.x = pkbf(v0[0] * sigm(v0[1]), v0[2] * sigm(v0[3])); w.y = pkbf(v1[0] * sigm(v1[1]), v1[2] * sigm(v1[3]));
                        *(u32x2*)(base + (size_t)row * 1024 + bj * 64) = w; } }
        }
    }
};
struct EpiMlIn {
    static constexpr bool PERM = true, AFTER_DRAIN = false;
    bf16_t* QK; size_t sec; float* G;
    __device__ __forceinline__ void operator()(const f32x4 (&acc)[2][2][4][2], const Unit& u, int wr, int wc, int fr, int fq) const {
        const int pn = u.pn, row0 = u.pm * BM + wr * 64 + fr, cbase = wc * 32 + 8 * fq;
        if (pn < 24) {
            bf16_t* base = QK + (size_t)(pn >> 3) * sec + (pn & 7) * 256 + cbase;
#pragma unroll
            for (int ai = 0; ai < 2; ++ai)
#pragma unroll
                for (int m = 0; m < 4; ++m) { const int row = row0 + ai * HALF + m * 16;
#pragma unroll
                    for (int bj = 0; bj < 2; ++bj) *(u32x4*)(base + (size_t)row * 2048 + bj * HALF) = pk8(acc[ai][bj][m][0], acc[ai][bj][m][1]); }
        } else if (wc == 0) {
#pragma unroll
            for (int ai = 0; ai < 2; ++ai)
#pragma unroll
                for (int m = 0; m < 4; ++m) { const int row = row0 + ai * HALF + m * 16; float* gp = G + (size_t)row * 32 + 8 * fq;
                    *(f32x4*)gp = acc[ai][0][m][0]; *(f32x4*)(gp + 4) = acc[ai][0][m][1]; }
        }
    }
};
}
#define LAS __attribute__((address_space(3)))
typedef unsigned short bf16;
typedef float f32x4 __attribute__((ext_vector_type(4)));
typedef unsigned u32x4 __attribute__((ext_vector_type(4)));
typedef unsigned u32x2 __attribute__((ext_vector_type(2)));
typedef short bf16x8 __attribute__((ext_vector_type(8)));
constexpr int DM = 2048, NB = 4, SEQL = 4096, CTXL = 256, MLAT = NB * SEQL, MCTX = NB * CTXL, MTOT = MLAT + MCTX, DFF = 8192;
constexpr float EPSN = 1e-6f;
constexpr size_t MiB = 1u << 20;
constexpr size_t WS_MOD = 0, WS_ROPE = 512 * 1024, WS_FFN1_0 = 1 * MiB, WS_FFN2_0 = 33 * MiB, WS_FFN1_1 = 65 * MiB, WS_FFN2_1 = 97 * MiB, WS_HYIN = 129 * MiB, WS_HYOUT = 149 * MiB,
                 WS_MLIN = 157 * MiB, WS_MLOUT = 182 * MiB, WS_XC = 190 * MiB, WS_H = 198 * MiB, WS_Y = 266 * MiB, WS_R = 402 * MiB,
                 WS_Q = WS_R, WS_K = WS_R + 34 * MiB, WS_V = WS_R + 68 * MiB, WS_UG = WS_R + 102 * MiB, WS_AO = WS_R + 136 * MiB, WS_HFF = WS_R,
                 WS_QKRAW = WS_R, WS_HF = WS_R, WS_V1 = WS_R + 68 * MiB, WS_AO1 = WS_R + 68 * MiB, WS_O1 = WS_R + 136 * MiB, WS_QKC = WS_R + 204 * MiB, WS_HB = WS_R + 272 * MiB,
                 WS_G = WS_R + 336 * MiB, WS_END = WS_R + 345 * MiB, WS_YP = WS_R + 272 * MiB, WS_SCP = WS_R + 339 * MiB, WS_SCH = WS_R + 344 * MiB;
constexpr size_t WS_BAR = 576 * 1024, WS_ZERO_BYTES = 640 * 1024;
constexpr int MODSZ = 5 * 12288;
constexpr int LDS_BYTES = 147456;

struct Params { const float* in[29]; float* out; unsigned char* ws; int ph_lo, ph_hi; };

__device__ __forceinline__ unsigned pk2(float lo, float hi) { typedef float f2 __attribute__((ext_vector_type(2))); typedef __bf16 b2 __attribute__((ext_vector_type(2))); f2 v = {lo, hi}; b2 b = __builtin_convertvector(v, b2); return __builtin_bit_cast(unsigned, b); }
__device__ __forceinline__ float bflo(unsigned w) { return __uint_as_float(w << 16); }
__device__ __forceinline__ float bfhi(unsigned w) { return __uint_as_float(w & 0xffff0000u); }
__device__ __forceinline__ float bf1(bf16 b) { return __uint_as_float((unsigned)b << 16); }
__device__ __forceinline__ float wave_sum(float v) {
#pragma unroll
    for (int o = 1; o < 64; o <<= 1) v += __shfl_xor(v, o);
    return v;
}
__device__ __forceinline__ float sigmf(float x) { return 1.0f / (1.0f + __expf(-x)); }

__device__ __forceinline__ int dst_row(int mode, int n) {
    if (mode == 1) {
        if (n < 2048) { const int d = n & 63, q = d >> 4, i = d & 15; const int dp = (q >> 1) * 32 + 2 * i + (q & 1); return (n & ~63) | dp; }
        if (n < 3072) return n;
        const int uu = n - 3072; return 3072 + 2 * (uu & 1023) + (uu >> 10);
    }
    if (mode == 2) {
        if (n < 4096) return n;
        if (n < 4128) return 6144 + (n - 4096);
        return 4096 + (n - 4128);
    }
    return n;
}
__device__ __forceinline__ void transpose_item(const float* W, int K, int N, bf16* WT, int mode, LAS float* scr, int item, int lane) {
    const int nblk = (N + 63) / 64, kb = item / nblk, nb = item % nblk, k0 = 64 * kb, n0 = 64 * nb;
    const bool okn = n0 + lane < N; const float* src = W + (size_t)k0 * N + n0 + lane;
    float t[64];
#pragma unroll
    for (int i = 0; i < 64; ++i) t[i] = okn ? src[(size_t)i * N] : 0.f;
#pragma unroll
    for (int i = 0; i < 64; ++i) scr[i * 65 + lane] = t[i];
    asm volatile("s_waitcnt lgkmcnt(0)" ::: "memory");
    const int c = lane & 7;
#pragma unroll
    for (int j = 0; j < 8; ++j) { const int n = (lane >> 3) + 8 * j; const LAS float* s = scr + (8 * c) * 65 + n;
        u32x4 o; o.x = pk2(s[0 * 65], s[1 * 65]); o.y = pk2(s[2 * 65], s[3 * 65]); o.z = pk2(s[4 * 65], s[5 * 65]); o.w = pk2(s[6 * 65], s[7 * 65]);
        if (n0 + n < N) *(u32x4*)(WT + (size_t)dst_row(mode, n0 + n) * K + k0 + 8 * c) = o; }
    asm volatile("s_waitcnt lgkmcnt(0)" ::: "memory");
}
__device__ __forceinline__ void ph_prologue(const Params& p, LAS unsigned char* lds) {
    const int tid = threadIdx.x, lane = tid & 63, wave = __builtin_amdgcn_readfirstlane(tid >> 6);
    const int gw = blockIdx.x * 8 + wave, NGW = gridDim.x * 8;
    LAS float* sl = (LAS float*)lds;
    LAS float* scr = (LAS float*)(lds + wave * 16640);
    { f32x4 cv[5];
#pragma unroll
      for (int q = 0; q < 5; ++q) { const int i4 = tid + 512 * q, s = i4 >> 9, k4 = i4 & 511; cv[q] = s < 4 ? *(const f32x4*)(p.in[1] + s * 2048 + 4 * k4) : *(const f32x4*)(p.in[3] + 4 * k4); }
#pragma unroll
      for (int q = 0; q < 5; ++q) { const int i4 = tid + 512 * q; f32x4 o;
#pragma unroll
        for (int e = 0; e < 4; ++e) o[e] = cv[q][e] / (1.0f + __expf(-cv[q][e]));
        *(LAS f32x4*)(sl + 4 * i4) = o; } }
    if (blockIdx.x == 0) {
        float* rope = (float*)(p.ws + WS_ROPE);
        for (int i = tid; i < 1024; i += 512) { const int pos = i >> 4, fi = i & 15; const double x = (double)exp2f(-(float)fi * 0.83048202372184058696f);
            double s = 0.0, c = 0.0, ts = x, tc = 1.0; const double x2 = x * x;
            for (int n = 0; n < 12; ++n) { c += tc; s += ts; tc = -tc * x2 / (double)((2 * n + 1) * (2 * n + 2)); ts = -ts * x2 / (double)((2 * n + 2) * (2 * n + 3)); }
            double cr = 1.0, sr = 0.0; for (int q = 0; q < pos; ++q) { const double nc = cr * c - sr * s, ns = sr * c + cr * s; cr = nc; sr = ns; }
            rope[2 * i] = (float)cr; rope[2 * i + 1] = (float)sr; }
    }
    __syncthreads();
    float* MOD = (float*)(p.ws + WS_MOD);
    for (int it = gw; it < 2 * 48 * 32; it += NGW) {
        const int l = it / 1536, r = it % 1536, ng = r >> 5, kc = r & 31, n = ng * 256 + 4 * lane;
        const float* W = p.in[4] + (size_t)l * 2048 * 12288 + (size_t)(kc * 64) * 12288 + n;
        f32x4 a0 = {0.f, 0.f, 0.f, 0.f}, a1 = a0, a2 = a0, a3 = a0, a4 = a0;
#pragma unroll 16
        for (int k = 0; k < 64; ++k) { const f32x4 w = *(const f32x4*)(W + (size_t)k * 12288); const int kk = kc * 64 + k;
            a0 += sl[kk] * w; a1 += sl[2048 + kk] * w; a2 += sl[4096 + kk] * w; a3 += sl[6144 + kk] * w; a4 += sl[8192 + kk] * w; }
        if (kc == 0) { const f32x4 b = *(const f32x4*)(p.in[5] + l * 12288 + n); a0 += b; a1 += b; a2 += b; a3 += b; a4 += b; }
        float* m = MOD + l * MODSZ + n;
#pragma unroll
        for (int e = 0; e < 4; ++e) {
            __hip_atomic_fetch_add(m + e, a0[e], __ATOMIC_RELAXED, __HIP_MEMORY_SCOPE_AGENT); __hip_atomic_fetch_add(m + 12288 + e, a1[e], __ATOMIC_RELAXED, __HIP_MEMORY_SCOPE_AGENT);
            __hip_atomic_fetch_add(m + 2 * 12288 + e, a2[e], __ATOMIC_RELAXED, __HIP_MEMORY_SCOPE_AGENT); __hip_atomic_fetch_add(m + 3 * 12288 + e, a3[e], __ATOMIC_RELAXED, __HIP_MEMORY_SCOPE_AGENT);
            __hip_atomic_fetch_add(m + 4 * 12288 + e, a4[e], __ATOMIC_RELAXED, __HIP_MEMORY_SCOPE_AGENT); }
    }
    __syncthreads();
    constexpr int I_F = 32 * 128, I_HI = 32 * 80, I_HO = 32 * 32, NIT = 2 * I_F + I_HI + I_HO;
    for (int it = gw; it < NIT; it += NGW) {
        int r = it;
        if (r < I_F) { transpose_item(p.in[10], 2048, 8192, (bf16*)(p.ws + WS_FFN1_0), 0, scr, r, lane); continue; } r -= I_F;
        if (r < I_F) { transpose_item(p.in[11], 8192, 2048, (bf16*)(p.ws + WS_FFN2_0), 0, scr, r, lane); continue; } r -= I_F;
        if (r < I_HI) { transpose_item(p.in[12], 2048, 5120, (bf16*)(p.ws + WS_HYIN), 1, scr, r, lane); continue; } r -= I_HI;
        transpose_item(p.in[13], 2048, 2048, (bf16*)(p.ws + WS_HYOUT), 0, scr, r, lane);
    }
}
__device__ __forceinline__ void tail_items(const Params& p, LAS unsigned char* lds, int nunits, int set) {
    const int G = gridDim.x, c = blockIdx.x, maxu = (nunits + G - 1) / G, nfull = nunits - (maxu - 1) * G;
    int idx = c, cnt = G;
    if (nfull != G) { if (c < nfull) return; idx = c - nfull; cnt = G - nfull; }
    const int lane = threadIdx.x & 63, wave = __builtin_amdgcn_readfirstlane(threadIdx.x >> 6), gw = idx * 8 + wave, NGW = cnt * 8;
    LAS float* scr = (LAS float*)(lds + wave * 16640);
    constexpr int I_F = 32 * 128, I_MI = 32 * 97, I_MO = 32 * 32;
    if (set == 0) { for (int it = gw; it < I_MI + I_MO + 1024; it += NGW) { if (it < I_MI) transpose_item(p.in[23], 2048, 6176, (bf16*)(p.ws + WS_MLIN), 2, scr, it, lane); else if (it < I_MI + I_MO) transpose_item(p.in[28], 2048, 2048, (bf16*)(p.ws + WS_MLOUT), 0, scr, it - I_MI, lane);
            else transpose_item(p.in[11] + (size_t)2048 * 8192, 8192, 2048, (bf16*)(p.ws + WS_FFN2_1), 0, scr, it - (I_MI + I_MO) + 3072, lane); } }
    else if (set == 1) { for (int it = gw; it < I_F; it += NGW) transpose_item(p.in[10] + (size_t)2048 * 8192, 2048, 8192, (bf16*)(p.ws + WS_FFN1_1), 0, scr, it, lane); }
    else { for (int it = gw; it < 3072; it += NGW) transpose_item(p.in[11] + (size_t)2048 * 8192, 8192, 2048, (bf16*)(p.ws + WS_FFN2_1), 0, scr, it, lane); }
}

template <class P4>
__device__ __forceinline__ void row_finish(const Params& p, int r, f32x4 (&v)[8], f32x4 (&y)[8], bool has_y, bool has_next, P4 gate, P4 gpost, P4 sh, P4 sc, P4 gnext, int lane) {
    float* XC = (float*)(p.ws + WS_XC); bf16* H = (bf16*)(p.ws + WS_H);
    const bool lat = r < MLAT;
    float* xout = lat ? (p.out + (size_t)r * DM) : (XC + (size_t)(r - MLAT) * DM);
    if (has_y) {
        float ss = 0.f;
#pragma unroll
        for (int j = 0; j < 8; ++j) ss += (y[j][0] * y[j][0] + y[j][1] * y[j][1]) + (y[j][2] * y[j][2] + y[j][3] * y[j][3]);
        const float rs = rsqrtf(wave_sum(ss) * (1.0f / DM) + EPSN);
#pragma unroll
        for (int j = 0; j < 8; ++j) { const int c = 4 * lane + 256 * j; const f32x4 g = gate[lane + 64 * j], gp = gpost[lane + 64 * j];
            v[j] += g * (y[j] * rs * gp); *(f32x4*)(xout + c) = v[j]; if (j & 1) asm volatile("" ::: "memory"); }
    }
    if (has_next) {
        float ss = 0.f;
#pragma unroll
        for (int j = 0; j < 8; ++j) ss += (v[j][0] * v[j][0] + v[j][1] * v[j][1]) + (v[j][2] * v[j][2] + v[j][3] * v[j][3]);
        const float rs = rsqrtf(wave_sum(ss) * (1.0f / DM) + EPSN);
#pragma unroll
        for (int j = 0; j < 8; ++j) { const int c = 4 * lane + 256 * j; const f32x4 a = sh[lane + 64 * j], b = sc[lane + 64 * j], g = gnext[lane + 64 * j];
            const f32x4 h = (v[j] * rs * g) * (1.0f + b) + a; u32x2 w; w.x = pk2(h[0], h[1]); w.y = pk2(h[2], h[3]); *(u32x2*)(H + (size_t)r * DM + c) = w; if (j & 1) asm volatile("" ::: "memory"); }
    }
}
__device__ __forceinline__ void ph_rows(const Params& p, LAS unsigned char* lds, int nrows, bool first, bool has_y, int lcur, int gate_idx, const float* gpost, bool has_next, int lnext, int shift_idx, const float* gnext, bool ctx_split = false) {
    const int lane = threadIdx.x & 63, wave = __builtin_amdgcn_readfirstlane(threadIdx.x >> 6), gw = blockIdx.x * 8 + wave, NGW = gridDim.x * 8;
    const float* MOD = (const float*)(p.ws + WS_MOD);
    const bf16* Y = (const bf16*)(p.ws + WS_Y); const float* XC = (const float*)(p.ws + WS_XC);
    const float* xl = first ? p.in[0] : p.out;
    LAS float* L = (LAS float*)lds;
    for (int i = threadIdx.x * 4; i < 2048; i += 2048) {
        if (has_y) *(LAS f32x4*)(L + i) = *(const f32x4*)(gpost + i);
        if (has_next) *(LAS f32x4*)(L + 2048 + i) = *(const f32x4*)(gnext + i);
#pragma unroll
        for (int s = 0; s < 4; ++s) {
            if (has_y) *(LAS f32x4*)(L + 4096 + 6144 * s + i) = *(const f32x4*)(MOD + lcur * MODSZ + s * 12288 + gate_idx * 2048 + i);
            if (has_next) { *(LAS f32x4*)(L + 4096 + 6144 * s + 2048 + i) = *(const f32x4*)(MOD + lnext * MODSZ + s * 12288 + shift_idx * 2048 + i);
                            *(LAS f32x4*)(L + 4096 + 6144 * s + 4096 + i) = *(const f32x4*)(MOD + lnext * MODSZ + s * 12288 + (shift_idx + 1) * 2048 + i); } }
    }
    __syncthreads();
    if (MLAT % (2 * NGW) == 0) {
        f32x4 ax[8], bx[8]; u32x2 ay[8], by[8];
#pragma unroll
        for (int j = 0; j < 8; ++j) { ay[j] = (u32x2){0u, 0u}; by[j] = ay[j];
            ax[j] = __builtin_nontemporal_load((const f32x4*)(xl + (size_t)gw * DM + 4 * lane + 256 * j)); if (has_y) ay[j] = __builtin_nontemporal_load((const u32x2*)(Y + (size_t)gw * DM + 4 * lane + 256 * j)); }
#pragma unroll
        for (int j = 0; j < 8; ++j) { bx[j] = __builtin_nontemporal_load((const f32x4*)(xl + (size_t)(gw + NGW) * DM + 4 * lane + 256 * j)); if (has_y) by[j] = __builtin_nontemporal_load((const u32x2*)(Y + (size_t)(gw + NGW) * DM + 4 * lane + 256 * j)); }
        for (int r = gw; r < MLAT; r += 2 * NGW) {
            { f32x4 v[8], y[8];
#pragma unroll
              for (int j = 0; j < 8; ++j) { v[j] = ax[j]; y[j] = (f32x4){bflo(ay[j].x), bfhi(ay[j].x), bflo(ay[j].y), bfhi(ay[j].y)}; }
              const int rn = (r + 2 * NGW < MLAT) ? r + 2 * NGW : r;
#pragma unroll
              for (int j = 0; j < 8; ++j) { ax[j] = __builtin_nontemporal_load((const f32x4*)(xl + (size_t)rn * DM + 4 * lane + 256 * j)); if (has_y) ay[j] = __builtin_nontemporal_load((const u32x2*)(Y + (size_t)rn * DM + 4 * lane + 256 * j)); }
              const LAS f32x4* Ls = (const LAS f32x4*)(L + 4096 + 6144 * (r >> 12));
              row_finish<const LAS f32x4*>(p, r, v, y, has_y, has_next, Ls, (const LAS f32x4*)L, Ls + 512, Ls + 1024, (const LAS f32x4*)(L + 2048), lane); }
            { const int r2 = r + NGW; f32x4 v[8], y[8];
#pragma unroll
              for (int j = 0; j < 8; ++j) { v[j] = bx[j]; y[j] = (f32x4){bflo(by[j].x), bfhi(by[j].x), bflo(by[j].y), bfhi(by[j].y)}; }
              const int rn = (r2 + 2 * NGW < MLAT) ? r2 + 2 * NGW : r2;
#pragma unroll
              for (int j = 0; j < 8; ++j) { bx[j] = __builtin_nontemporal_load((const f32x4*)(xl + (size_t)rn * DM + 4 * lane + 256 * j)); if (has_y) by[j] = __builtin_nontemporal_load((const u32x2*)(Y + (size_t)rn * DM + 4 * lane + 256 * j)); }
              const LAS f32x4* Ls = (const LAS f32x4*)(L + 4096 + 6144 * (r2 >> 12));
              row_finish<const LAS f32x4*>(p, r2, v, y, has_y, has_next, Ls, (const LAS f32x4*)L, Ls + 512, Ls + 1024, (const LAS f32x4*)(L + 2048), lane); }
        }
    } else {
    f32x4 nx[8]; u32x2 ny[8];
#pragma unroll
    for (int j = 0; j < 8; ++j) { nx[j] = (f32x4){0.f, 0.f, 0.f, 0.f}; ny[j] = (u32x2){0u, 0u}; }
    if (gw < MLAT) {
#pragma unroll
        for (int j = 0; j < 8; ++j) { nx[j] = __builtin_nontemporal_load((const f32x4*)(xl + (size_t)gw * DM + 4 * lane + 256 * j)); if (has_y) ny[j] = __builtin_nontemporal_load((const u32x2*)(Y + (size_t)gw * DM + 4 * lane + 256 * j)); } }
    for (int r = gw; r < MLAT; r += NGW) {
        f32x4 v[8], y[8];
#pragma unroll
        for (int j = 0; j < 8; ++j) { v[j] = nx[j]; y[j] = (f32x4){bflo(ny[j].x), bfhi(ny[j].x), bflo(ny[j].y), bfhi(ny[j].y)}; }
        const int rn = (r + NGW < MLAT) ? r + NGW : r;
#pragma unroll
        for (int j = 0; j < 8; ++j) { nx[j] = __builtin_nontemporal_load((const f32x4*)(xl + (size_t)rn * DM + 4 * lane + 256 * j)); if (has_y) ny[j] = __builtin_nontemporal_load((const u32x2*)(Y + (size_t)rn * DM + 4 * lane + 256 * j)); }
        const LAS f32x4* Ls = (const LAS f32x4*)(L + 4096 + 6144 * (r >> 12));
        row_finish<const LAS f32x4*>(p, r, v, y, has_y, has_next, Ls, (const LAS f32x4*)L, Ls + 512, Ls + 1024, (const LAS f32x4*)(L + 2048), lane);
    }
    }
    for (int r = MLAT + gw; r < nrows; r += NGW) {
        const float* xin = (first ? p.in[2] : XC) + (size_t)(r - MLAT) * DM;
        f32x4 v[8], y[8];
#pragma unroll
        for (int j = 0; j < 8; ++j) v[j] = *(const f32x4*)(xin + 4 * lane + 256 * j);
        if (has_y) {
            if (ctx_split) {
#pragma unroll
                for (int j = 0; j < 8; ++j) y[j] = (f32x4){0.f, 0.f, 0.f, 0.f};
#pragma unroll 1
                for (int ks = 0; ks < 8; ++ks) { const float* yp = (const float*)(p.ws + WS_YP) + (size_t)ks * MCTX * DM + (size_t)(r - MLAT) * DM + 4 * lane;
#pragma unroll
                    for (int j = 0; j < 8; ++j) y[j] += *(const f32x4*)(yp + 256 * j); } }
            else {
#pragma unroll
                for (int j = 0; j < 8; ++j) { const u32x2 yw = __builtin_nontemporal_load((const u32x2*)(Y + (size_t)r * DM + 4 * lane + 256 * j)); y[j] = (f32x4){bflo(yw.x), bfhi(yw.x), bflo(yw.y), bfhi(yw.y)}; } } }
        else {
#pragma unroll
            for (int j = 0; j < 8; ++j) y[j] = (f32x4){0.f, 0.f, 0.f, 0.f}; }
        const float* gm = MOD + lcur * MODSZ + 4 * 12288 + gate_idx * 2048; const float* sm = MOD + lnext * MODSZ + 4 * 12288 + shift_idx * 2048;
        row_finish<const f32x4*>(p, r, v, y, has_y, has_next, (const f32x4*)gm, (const f32x4*)gpost, (const f32x4*)sm, (const f32x4*)(sm + 2048), (const f32x4*)gnext, lane);
    }
}
#define RLX_AGENT __ATOMIC_RELAXED, __HIP_MEMORY_SCOPE_AGENT
#define LDS_WAIT() asm volatile("s_waitcnt lgkmcnt(0)" ::: "memory")
#define XB_TMO      128
#define XB_XCNT(j)  (256  + 64 * (j))
#define XB_XSUB(j)  (1280 + 64 * (j))
#define XB_XGEN(j)  (2304 + 64 * (j))
#define XB_TOP      3328
#define XB_TOPGEN   3392
#define XCD_BAR_WORDS 3456
#define XB_SPIN_CAP (1u << 18)

__device__ __forceinline__ unsigned xb_ld(unsigned* p)              { return __hip_atomic_load(p, __ATOMIC_RELAXED, __HIP_MEMORY_SCOPE_AGENT); }
__device__ __forceinline__ unsigned xb_add(unsigned* p, unsigned v) { return __hip_atomic_fetch_add(p, v, __ATOMIC_RELAXED, __HIP_MEMORY_SCOPE_AGENT); }
__device__ __forceinline__ unsigned xb_xcc_id() { return (unsigned)__builtin_amdgcn_s_getreg((3 << 11) | 20) & 0xFu; }
#define XB_SPIN(cond, bar) do { unsigned _sp = 0; while (cond) { __builtin_amdgcn_s_sleep(1); \
    if ((++_sp & 255u) == 0u) { if (xb_ld(&(bar)[XB_TMO])) break; if (_sp > XB_SPIN_CAP) { atomicAdd(&(bar)[XB_TMO], 1u); break; } } } } while (0)

struct XcdBarrier {
    unsigned* bar; unsigned x;
    volatile LAS unsigned* st;
};

__device__ __forceinline__ XcdBarrier xcd_barrier_post(unsigned* bar, volatile LAS unsigned* st) {
    XcdBarrier b; b.bar = bar; b.x = xb_xcc_id(); b.st = st;
    if (threadIdx.x == 0) (void)xb_add(&bar[XB_XCNT(b.x)], 1u);
    return b;
}
__device__ __forceinline__ void xcd_barrier_complete(unsigned* bar, unsigned x, unsigned& nloc, unsigned& nx) {
    const unsigned G = gridDim.x * gridDim.y * gridDim.z;
    unsigned sum, cnt, mine, sp = 0u;
    for (;;) {
        sum = 0u; cnt = 0u; mine = 0u;
#pragma unroll
        for (unsigned j = 0; j < 16; ++j) { const unsigned c = xb_ld(&bar[XB_XCNT(j)]); sum += c; cnt += (c > 0u) ? 1u : 0u; mine = (j == x) ? c : mine; }
        if (sum == G) break;
        __builtin_amdgcn_s_sleep(1);
        if ((++sp & 255u) == 0u) { if (xb_ld(&bar[XB_TMO])) break; if (sp > XB_SPIN_CAP) { atomicAdd(&bar[XB_TMO], 1u); break; } }
    }
    nloc = mine > 0u ? mine : 1u; nx = cnt > 0u ? cnt : 1u;
}

__device__ __forceinline__ void xcd_barrier(const XcdBarrier& b) {
    asm volatile("s_waitcnt vmcnt(0)" ::: "memory");
    __syncthreads();
    if (threadIdx.x == 0) {
        unsigned* bar = b.bar;
        __builtin_amdgcn_s_waitcnt(0);
        unsigned nloc = b.st[0], nx = b.st[1];
        if (nloc == 0u) { xcd_barrier_complete(bar, b.x, nloc, nx); b.st[0] = nloc; b.st[1] = nx; }
        const unsigned old = xb_add(&bar[XB_XSUB(b.x)], 1u);
        const unsigned gen = old / nloc;
        if (old + 1u == (gen + 1u) * nloc) {
            __builtin_amdgcn_fence(__ATOMIC_RELEASE, "agent");
            asm volatile("s_waitcnt vmcnt(0)" ::: "memory");
            const unsigned og = xb_add(&bar[XB_TOP], 1u);
            const unsigned tg = og / nx;
            if (og + 1u == (tg + 1u) * nx) xb_add(&bar[XB_TOPGEN], 1u);
            else XB_SPIN(xb_ld(&bar[XB_TOPGEN]) == tg, bar);
            __builtin_amdgcn_fence(__ATOMIC_ACQUIRE, "agent");
            xb_add(&bar[XB_XGEN(b.x)], 1u);
            asm volatile("s_waitcnt vmcnt(0)" ::: "memory");
        } else {
            XB_SPIN(xb_ld(&bar[XB_XGEN(b.x)]) == gen, bar);
            __builtin_amdgcn_fence(__ATOMIC_ACQUIRE, "agent");
            asm volatile("s_waitcnt vmcnt(0)" ::: "memory");
        }
    }
    __syncthreads();
}
namespace att {
using f32x16 = __attribute__((ext_vector_type(16))) float;
using s16x4 = __attribute__((ext_vector_type(4))) short;
constexpr float SCALE = 0.125f, THR = 8.f;
constexpr int SHM_V = 64 * 128 * 2, SHM_K = 64 * 128 * 2;
#define KSWZ(row, colB) ((row) * 256 + ((colB) ^ (((row) & 15) << 4)))
#define SBAR() __builtin_amdgcn_sched_barrier(0)
__device__ __forceinline__ int crow(int r, int hi) { return (r & 3) + 8 * (r >> 2) + 4 * hi; }
__device__ __forceinline__ unsigned cvtpk(float lo, float hi) { unsigned r; asm volatile("v_cvt_pk_bf16_f32 %0, %1, %2" : "=v"(r) : "v"(lo), "v"(hi)); return r; }
__device__ __forceinline__ void partialSM(f32x16& p0, f32x16& p1, float& m_reg, float& mn, float& alpha) {
  constexpr float C = SCALE * 1.4426950408889634f;
  float pmax = p0[0];
#pragma unroll
  for (int r = 1; r < 16; ++r) pmax = fmaxf(pmax, p0[r]);
#pragma unroll
  for (int r = 0; r < 16; ++r) pmax = fmaxf(pmax, p1[r]);
  { auto rr = __builtin_amdgcn_permlane32_swap(__float_as_uint(pmax), __float_as_uint(pmax), false, false);
    pmax = fmaxf(__uint_as_float(rr[0]), __uint_as_float(rr[1])); }
  if (__builtin_expect(__all(pmax - m_reg <= THR / SCALE), 1)) { mn = m_reg; alpha = 1.f; }
  else { mn = fmaxf(m_reg, pmax); alpha = __builtin_amdgcn_exp2f((m_reg - mn) * C); m_reg = mn; }
  float mnC = -mn * C;
#pragma unroll
  for (int r = 0; r < 16; ++r) p0[r] = fmaf(p0[r], C, mnC);
#pragma unroll
  for (int r = 0; r < 16; ++r) p1[r] = fmaf(p1[r], C, mnC);
#pragma unroll
  for (int r = 0; r < 16; ++r) p0[r] = __builtin_amdgcn_exp2f(p0[r]);
}
__device__ __forceinline__ void finishSM(f32x16& p0, f32x16& p1, float alpha, float& l_reg, bf16x8& pa0, bf16x8& pa1, bf16x8& pa2, bf16x8& pa3) {
#pragma unroll
  for (int r = 0; r < 16; ++r) p1[r] = __builtin_amdgcn_exp2f(p1[r]);
  float ps = 0;
#pragma unroll
  for (int r = 0; r < 16; ++r) ps += p0[r];
#pragma unroll
  for (int r = 0; r < 16; ++r) ps += p1[r];
  { auto rr = __builtin_amdgcn_permlane32_swap(__float_as_uint(ps), __float_as_uint(ps), false, false);
    ps = __uint_as_float(rr[0]) + __uint_as_float(rr[1]); }
  l_reg = l_reg * alpha + ps;
#define PK4(P, BASE, OUT) do { unsigned a0 = cvtpk(P[BASE + 0], P[BASE + 1]), a1 = cvtpk(P[BASE + 2], P[BASE + 3]);   \
    unsigned b0 = cvtpk(P[BASE + 4], P[BASE + 5]), b1 = cvtpk(P[BASE + 6], P[BASE + 7]);                              \
    auto r0 = __builtin_amdgcn_permlane32_swap(a0, b0, false, false); auto r1 = __builtin_amdgcn_permlane32_swap(a1, b1, false, false); \
    u32x4 w = {r0[0], r1[0], r0[1], r1[1]}; OUT = *reinterpret_cast<bf16x8*>(&w); } while (0)
  PK4(p0, 0, pa0); PK4(p0, 8, pa1); PK4(p1, 0, pa2); PK4(p1, 8, pa3);
#undef PK4
}
__device__ __forceinline__ void qkt(f32x16& p0, f32x16& p1, const char* Ks, const bf16x8* qr, int r32, int hi, int comp) {
  p0 = f32x16{}; p1 = f32x16{};
#pragma unroll
  for (int d0 = 0; d0 < 4; ++d0) { const int cb = ((comp * 4 + d0) * 16 + hi * 8) * 2;
    bf16x8 b0 = *reinterpret_cast<const bf16x8*>(Ks + KSWZ(r32, cb));
    bf16x8 b1 = *reinterpret_cast<const bf16x8*>(Ks + KSWZ(32 + r32, cb));
    p0 = __builtin_amdgcn_mfma_f32_32x32x16_bf16(b0, qr[d0], p0, 0, 0, 0);
    p1 = __builtin_amdgcn_mfma_f32_32x32x16_bf16(b1, qr[d0], p1, 0, 0, 0); }
}
__device__ __forceinline__ int v_st(int k, int c) { const int kk = (k & ~0xC) | ((k & 4) << 1) | ((k & 8) >> 1); return ((kk >> 3) * 4 + (c >> 5)) * 512 + ((kk & 7) * 32 + (c & 31)) * 2; }
__device__ __forceinline__ int v_rd_base(int lane) { return ((lane & 3) << 3) | (((lane >> 2) & 3) << 6) | (((lane >> 4) & 1) << 5) | (((lane >> 5) & 1) << 8); }
constexpr int v_rd_off(int d0, int ks, int half) { return d0 * 512 + ks * 4096 + half * 2048; }
template <int OFF> __device__ __forceinline__ s16x4 tr_read(int vb) {
  s16x4 r; asm volatile("ds_read_b64_tr_b16 %0, %1 offset:%2" : "=&v"(r) : "v"(vb), "i"(OFF) : "memory"); return r;
}
template <int D0> __device__ __forceinline__ void pv_one(f32x16& od, int vb, bf16x8 pa0, bf16x8 pa1, bf16x8 pa2, bf16x8 pa3) {
  const s16x4 l0 = tr_read<v_rd_off(D0, 0, 0)>(vb), h0 = tr_read<v_rd_off(D0, 0, 1)>(vb), l1 = tr_read<v_rd_off(D0, 1, 0)>(vb), h1 = tr_read<v_rd_off(D0, 1, 1)>(vb);
  const s16x4 l2 = tr_read<v_rd_off(D0, 2, 0)>(vb), h2 = tr_read<v_rd_off(D0, 2, 1)>(vb), l3 = tr_read<v_rd_off(D0, 3, 0)>(vb), h3 = tr_read<v_rd_off(D0, 3, 1)>(vb);
  asm volatile("s_waitcnt lgkmcnt(0)" ::: "memory"); SBAR();
#define PK(L, H) (bf16x8){L[0], L[1], L[2], L[3], H[0], H[1], H[2], H[3]}
  od = __builtin_amdgcn_mfma_f32_32x32x16_bf16(pa0, PK(l0, h0), od, 0, 0, 0);
  od = __builtin_amdgcn_mfma_f32_32x32x16_bf16(pa1, PK(l1, h1), od, 0, 0, 0);
  od = __builtin_amdgcn_mfma_f32_32x32x16_bf16(pa2, PK(l2, h2), od, 0, 0, 0);
  od = __builtin_amdgcn_mfma_f32_32x32x16_bf16(pa3, PK(l3, h3), od, 0, 0, 0);
#undef PK
}
__device__ __forceinline__ void pv_d0(f32x16* o, int vb, bf16x8 pa0, bf16x8 pa1, bf16x8 pa2, bf16x8 pa3) {
  pv_one<0>(o[0], vb, pa0, pa1, pa2, pa3); pv_one<1>(o[1], vb, pa0, pa1, pa2, pa3); pv_one<2>(o[2], vb, pa0, pa1, pa2, pa3); pv_one<3>(o[3], vb, pa0, pa1, pa2, pa3);
}
__device__ __forceinline__ void attn_unit(const bf16* __restrict__ Qg, const bf16* __restrict__ Kg, const bf16* __restrict__ Vg, bf16* __restrict__ AO,
                                          int b, int h, int qrow0, int NT, float lam, const float* __restrict__ subg, char* lds) {
  const int tid = threadIdx.x, wid = tid >> 6, lane = tid & 63, r32 = lane & 31, hi = lane >> 5, comp = wid >> 2, wq = wid & 3;
  char* V_lds = lds; char* K_lds = lds + 2 * SHM_V;
  float* ws = (float*)(lds + 2 * SHM_V + 2 * SHM_K) + wid * 64; float* li_l = ws; float* al_l = ws + 32;
  float m_reg = -1e30f, l_reg = 0; f32x16 o[4] = {}; bf16x8 qr[4];
  const bf16* Qw = Qg + (size_t)(qrow0 + wq * 32 + r32) * 1024 + h * 128 + comp * 64 + hi * 8;
#pragma unroll
  for (int d0 = 0; d0 < 4; ++d0) qr[d0] = *reinterpret_cast<const bf16x8*>(Qw + d0 * 16);
  const int sr = tid >> 4, sc = (tid & 15) * 8, vst0 = v_st(sr, sc), vst1 = v_st(32 + sr, sc);
  const int vb0 = (int)(uintptr_t)V_lds + v_rd_base(lane);
  struct { bf16x8 vs0, vs1, ks0, ks1; } sr_[2];
  const int kctx = MLAT + b * 256, klat = b * 4096 - 256;
#define KROW(j) (((j) < 4 ? kctx : klat) + (j) * 64)
#define SLOAD(i, j) do { const size_t r0_ = (size_t)(KROW(j) + sr) * 1024 + h * 128 + sc; \
    sr_[i].vs0 = *reinterpret_cast<const bf16x8*>(Vg + r0_); sr_[i].vs1 = *reinterpret_cast<const bf16x8*>(Vg + r0_ + 32 * 1024); \
    sr_[i].ks0 = *reinterpret_cast<const bf16x8*>(Kg + r0_); sr_[i].ks1 = *reinterpret_cast<const bf16x8*>(Kg + r0_ + 32 * 1024); } while (0)
#define SWRITE(bb, i) do { *(bf16x8*)(V_lds + (bb) * SHM_V + vst0) = sr_[i].vs0; *(bf16x8*)(V_lds + (bb) * SHM_V + vst1) = sr_[i].vs1; const int kc = sc * 2; \
    *(bf16x8*)(K_lds + (bb) * SHM_K + KSWZ(sr, kc)) = sr_[i].ks0; *(bf16x8*)(K_lds + (bb) * SHM_K + KSWZ(32 + sr, kc)) = sr_[i].ks1; } while (0)
#define SWAIT() asm volatile("s_waitcnt vmcnt(4)" ::: "memory")
#define RESC(a) do { if (__any((a) < 1.f)) { if (hi == 0) al_l[r32] = (a); asm volatile("s_waitcnt lgkmcnt(0)" ::: "memory"); \
    _Pragma("unroll") for (int d = 0; d < 4; ++d) _Pragma("unroll") for (int r = 0; r < 16; ++r) o[d][r] *= al_l[crow(r, hi)]; } } while (0)
  f32x16 pA0, pA1, pB0, pB1; float mnA, mnB, alA, alB; bf16x8 pa0, pa1, pa2, pa3;
  constexpr int SE = 0, SO = 1;
  SLOAD(SE, 0); asm volatile("s_waitcnt vmcnt(0)" ::: "memory"); SWRITE(0, SE); __syncthreads();
  qkt(pA0, pA1, K_lds, qr, r32, hi, comp); partialSM(pA0, pA1, m_reg, mnA, alA);
  SLOAD(SO, 1); if (2 < NT) SLOAD(SE, 2);
  SWAIT(); SWRITE(1, SO); __syncthreads();
  for (int j = 1; j + 1 < NT; j += 2) {
    SBAR(); qkt(pB0, pB1, K_lds + SHM_K, qr, r32, hi, comp);
    finishSM(pA0, pA1, alA, l_reg, pa0, pa1, pa2, pa3); SBAR();
    SLOAD(SO, j + 2); SBAR();
    pv_d0(o, vb0, pa0, pa1, pa2, pa3); partialSM(pB0, pB1, m_reg, mnB, alB);
    __syncthreads(); SWAIT(); SWRITE(0, SE);
    RESC(alB); __syncthreads();
    SBAR(); qkt(pA0, pA1, K_lds, qr, r32, hi, comp);
    finishSM(pB0, pB1, alB, l_reg, pa0, pa1, pa2, pa3); SBAR();
    SLOAD(SE, (j + 3 < NT) ? j + 3 : NT - 1); SBAR();
    pv_d0(o, vb0 + SHM_V, pa0, pa1, pa2, pa3); partialSM(pA0, pA1, m_reg, mnA, alA);
    __syncthreads(); SWAIT(); SWRITE(1, SO);
    RESC(alA); __syncthreads();
  }
  SBAR(); qkt(pB0, pB1, K_lds + SHM_K, qr, r32, hi, comp);
  finishSM(pA0, pA1, alA, l_reg, pa0, pa1, pa2, pa3); SBAR();
  pv_d0(o, vb0, pa0, pa1, pa2, pa3); partialSM(pB0, pB1, m_reg, mnB, alB);
  __syncthreads(); RESC(alB);
  finishSM(pB0, pB1, alB, l_reg, pa0, pa1, pa2, pa3); SBAR();
  pv_d0(o, vb0 + SHM_V, pa0, pa1, pa2, pa3);
  if (hi == 0) li_l[r32] = l_reg; asm volatile("s_waitcnt lgkmcnt(0)" ::: "memory");
  float rli[16]; const float sgn = comp ? -lam : 1.0f;
#pragma unroll
  for (int r = 0; r < 16; ++r) rli[r] = __builtin_amdgcn_rcpf(li_l[crow(r, hi)]) * sgn;
  __syncthreads();
  float* ex = (float*)lds + (size_t)wq * 4096 + lane;
  if (comp == 1) {
#pragma unroll
    for (int d0 = 0; d0 < 4; ++d0)
#pragma unroll
      for (int r = 0; r < 16; ++r) ex[(d0 * 16 + r) * 64] = o[d0][r] * rli[r];
  }
  __syncthreads();
  if (comp == 0) {
    float ss[16];
#pragma unroll
    for (int r = 0; r < 16; ++r) { float s = 0.f;
#pragma unroll
      for (int d0 = 0; d0 < 4; ++d0) { const float v = o[d0][r] * rli[r] + ex[(d0 * 16 + r) * 64]; o[d0][r] = v; s += v * v; }
      ss[r] = s; }
#pragma unroll
    for (int off = 1; off < 32; off <<= 1)
#pragma unroll
      for (int r = 0; r < 16; ++r) ss[r] += __shfl_xor(ss[r], off);
    float g[4];
#pragma unroll
    for (int d0 = 0; d0 < 4; ++d0) g[d0] = subg[32 * d0 + r32] * 0.8f;
    bf16* Ow = AO + (size_t)(qrow0 + wq * 32) * 2048 + h * 128 + r32;
#pragma unroll
    for (int r = 0; r < 16; ++r) { const float rs = rsqrtf(ss[r] * (1.0f / 128.f) + EPSN); const int orow = crow(r, hi);
#pragma unroll
      for (int d0 = 0; d0 < 4; ++d0) Ow[(size_t)orow * 2048 + d0 * 32] = (bf16)(pk2(o[d0][r] * rs * g[d0], 0.f) & 0xffffu); }
  }
  __syncthreads();
#undef KROW
#undef SLOAD
#undef SWRITE
#undef SWAIT
#undef RESC
}
#undef SBAR
#undef KSWZ
}

__device__ __forceinline__ void conv_item(const Params& p, int item, char* lds) {
  const int tid = threadIdx.x, lane = tid & 63, wave = tid >> 6, r0 = item * 16, c0 = 2 * tid;
  int s0, s1; if (r0 < MLAT) { s0 = r0 & ~4095; s1 = s0 + 4096; } else { s0 = MLAT + ((r0 - MLAT) & ~255); s1 = s0 + 256; }
  const bf16* UG = (const bf16*)(p.ws + WS_UG); bf16* AO = (bf16*)(p.ws + WS_AO);
  float* red = (float*)lds; float* stat = red + 256;
  float o0[16], o1[16];
#pragma unroll
  for (int t = 0; t < 16; ++t) { o0[t] = 0.f; o1[t] = 0.f; }
  {
    float w0[31], w1[31];
#pragma unroll
    for (int j = 0; j < 31; ++j) { const float2 w = *(const float2*)(p.in[19] + j * 1024 + c0); w0[j] = w.x; w1[j] = w.y; }
#pragma unroll
    for (int rr = 0; rr < 46; ++rr) { const int row = r0 - 15 + rr; unsigned xw = 0u;
      if (row >= s0 && row < s1) xw = *(const unsigned*)(UG + (size_t)row * 1024 + c0);
      const float x0 = bflo(xw), x1 = bfhi(xw);
#pragma unroll
      for (int t = 0; t < 16; ++t) { const int j = rr - t; if (j >= 0 && j <= 30) { o0[t] = fmaf(w0[j], x0, o0[t]); o1[t] = fmaf(w1[j], x1, o1[t]); } } }
  }
  const float2 cb = *(const float2*)(p.in[20] + c0);
  float v[32];
#pragma unroll
  for (int t = 0; t < 16; ++t) { o0[t] += cb.x; o1[t] += cb.y; v[t] = o0[t] + o1[t]; v[16 + t] = o0[t] * o0[t] + o1[t] * o1[t]; }
#pragma unroll
  for (int S = 16; S >= 1; S >>= 1) {
    const bool up = (lane & S) != 0;
#pragma unroll
    for (int k = 0; k < S; ++k) { const float a = v[k], bq = v[k + S]; const float keep = up ? bq : a, send = up ? a : bq; v[k] = keep + __shfl_xor(send, S); }
  }
  v[0] += __shfl_xor(v[0], 32);
  __syncthreads();
  if (lane < 32) red[wave * 32 + lane] = v[0];
  __syncthreads();
  if (tid < 16) { float S1 = 0.f, S2 = 0.f;
#pragma unroll
    for (int w = 0; w < 8; ++w) { S1 += red[w * 32 + tid]; S2 += red[w * 32 + 16 + tid]; }
    const float mean = S1 * (1.0f / 1024.f), var = fmaxf(S2 * (1.0f / 1024.f) - mean * mean, 0.f);
    stat[2 * tid] = mean; stat[2 * tid + 1] = rsqrtf(var + EPSN); }
  __syncthreads();
  const float2 lg = *(const float2*)(p.in[21] + c0), lb = *(const float2*)(p.in[22] + c0);
#pragma unroll
  for (int t = 0; t < 16; ++t) { const float mean = stat[2 * t], rstd = stat[2 * t + 1];
    float a = (o0[t] - mean) * rstd * lg.x + lb.x, bq = (o1[t] - mean) * rstd * lg.y + lb.y; a = a * sigmf(a); bq = bq * sigmf(bq);
    *(unsigned*)(AO + (size_t)(r0 + t) * 2048 + 1024 + c0) = pk2(a, bq); }
}
__device__ __forceinline__ void ph_mix0(const Params& p, char* lds) {
  const int G = gridDim.x, bx = blockIdx.x;
#ifndef NO_CONV
  for (int it = bx; it < MTOT / 16; it += G) conv_item(p, it, lds);
#endif
  __syncthreads();
  float lam;
  { float s1 = 0.f, s2 = 0.f; for (int i = 0; i < 64; ++i) { s1 += p.in[14][i] * p.in[15][i]; s2 += p.in[16][i] * p.in[17][i]; } lam = __expf(s1) - __expf(s2) + 0.2f; }
  const bf16* Qg = (const bf16*)(p.ws + WS_Q); const bf16* Kg = (const bf16*)(p.ws + WS_K); const bf16* Vg = (const bf16*)(p.ws + WS_V); bf16* AO = (bf16*)(p.ws + WS_AO);
#ifndef NO_ATT
  for (int u = bx; u < 1024 + 64; u += G) {
    if (u >= 1024 && G >= 128) break;
    if (u < 1024) { int bh = u >> 5, qb = u & 31; if (G == 256) { bh = (u >> 8) * 8 + (bx & 7); qb = bx >> 3; }
      const int b = bh >> 3, h = bh & 7; att::attn_unit(Qg, Kg, Vg, AO, b, h, b * 4096 + qb * 128, 68, lam, p.in[18], lds); }
    else { const int c = u - 1024, b = c >> 4, h = (c >> 1) & 7, hf = c & 1; att::attn_unit(Qg, Kg, Vg, AO, b, h, MLAT + b * 256 + hf * 128, 4, lam, p.in[18], lds); }
  }
  if (G >= 128 && bx >= G - 64) { const int c = bx - (G - 64), b = c >> 4, h = (c >> 1) & 7, hf = c & 1; att::attn_unit(Qg, Kg, Vg, AO, b, h, MLAT + b * 256 + hf * 128, 4, lam, p.in[18], lds); }
#endif
}
__device__ __forceinline__ float wscan_add(float v, int lane) {
#pragma unroll
  for (int o = 1; o < 64; o <<= 1) { const float t = __shfl_up(v, o); if (lane >= o) v += t; }
  return v;
}
__device__ __forceinline__ float wscan_max(float v, int lane) {
#pragma unroll
  for (int o = 1; o < 64; o <<= 1) { const float t = __shfl_up(v, o); if (lane >= o) v = fmaxf(v, t); }
  return v;
}
__device__ __forceinline__ int ml_row(int b, int dir, int s, int i) {
  return s < 4 ? (dir ? (MLAT + b * 256 + 255 - 64 * s - i) : (MLAT + b * 256 + 64 * s + i)) : (dir ? (b * 4096 + 4095 - 64 * (s - 4) - i) : (b * 4096 + 64 * (s - 4) + i));
}
__device__ __forceinline__ void ph_mlconv(const Params& p) {
  const bf16* QK = (const bf16*)(p.ws + WS_QKRAW); bf16* QC = (bf16*)(p.ws + WS_QKC);
  const float* cw = p.in[24]; const float* cbias = p.in[25];
  { const int lane = threadIdx.x & 63, gw = blockIdx.x * 8 + __builtin_amdgcn_readfirstlane(threadIdx.x >> 6), NGW = gridDim.x * 8;
    const float* G = (const float*)(p.ws + WS_G); f32x4* P = (f32x4*)(p.ws + WS_SCP); float* CH = (float*)(p.ws + WS_SCH);
    for (int it = gw; it < 64 * 68; it += NGW) { const int task = it / 68, s = it % 68, dir = task & 1, h = (task >> 1) & 7, b = task >> 4;
      const int gci = dir * 16 + h, gcf = gci + 8, row = ml_row(b, dir, s, lane);
      const float ig = G[(size_t)row * 32 + gci] + p.in[26][gci], fr = G[(size_t)row * 32 + gcf] + p.in[26][gcf];
      const float lf = fminf(fr, 0.f) - log1pf(__expf(-fabsf(fr))), bc = wscan_add(lf, lane), a = ig - bc, am = wscan_max(a, lane);
      P[(size_t)task * 4352 + 64 * s + lane] = (f32x4){a, am, bc, 0.f};
      if (lane == 63) { CH[(task * 68 + s) * 2] = bc; CH[(task * 68 + s) * 2 + 1] = am; } } }
  const int stride = gridDim.x * 512;
  for (int idx = blockIdx.x * 512 + threadIdx.x; idx < (MTOT / 8) * 256; idx += stride) {
    const int r0 = (idx >> 8) * 8, c = (idx & 255) * 8;
    int s0, s1; if (r0 < MLAT) { s0 = r0 & ~4095; s1 = s0 + 4096; } else { s0 = MLAT + ((r0 - MLAT) & ~255); s1 = s0 + 256; }
    const u32x4 z = {0u, 0u, 0u, 0u}; u32x4 x[10];
#pragma unroll
    for (int i = 0; i < 10; ++i) { const int r = r0 - 1 + i; x[i] = (r >= s0 && r < s1) ? *(const u32x4*)(QK + (size_t)r * 2048 + c) : z; }
    float w0[8], w1[8], w2[8], bb[8];
#pragma unroll
    for (int e = 0; e < 8; ++e) { w0[e] = cw[c + e]; w1[e] = cw[2048 + c + e]; w2[e] = cw[4096 + c + e]; bb[e] = cbias[c + e]; }
    const float ksc = (c >= 1024) ? 0.08838834764831845f : 1.0f;
#pragma unroll
    for (int i = 0; i < 8; ++i) { float y[8];
#pragma unroll
      for (int e = 0; e < 8; ++e) { const unsigned wm = x[i][e >> 1], wc = x[i + 1][e >> 1], wp = x[i + 2][e >> 1];
        const float a = (e & 1) ? bfhi(wm) : bflo(wm), b = (e & 1) ? bfhi(wc) : bflo(wc), d = (e & 1) ? bfhi(wp) : bflo(wp);
        float v = bb[e] + w0[e] * a + w1[e] * b + w2[e] * d; v = v * sigmf(v) * ksc; y[e] = v; }
      u32x4 o; o.x = pk2(y[0], y[1]); o.y = pk2(y[2], y[3]); o.z = pk2(y[4], y[5]); o.w = pk2(y[6], y[7]);
      *(u32x4*)(QC + (size_t)(r0 + i) * 2048 + c) = o; }
  }
}

namespace ml {
typedef float f4 __attribute__((ext_vector_type(4)));
typedef short s4 __attribute__((ext_vector_type(4)));
constexpr int QS = 0, KS = 17408, KT = 34816, VT = 53248, CT = 62464, NV = 79872, SC = 80384, PW = 82496, SCL = 84608, CHL = 136832;
constexpr int RS = 272, TS = 144;
#define MFMA16(a, b, c) __builtin_amdgcn_mfma_f32_16x16x32_bf16((a), (b), (c), 0, 0, 0)
#define ROT(row, c) (((((c) + ((row) >> 3)) & 7)) * 16)
__device__ __forceinline__ void mlstm_item(const Params& p, int item, char* lds) {
  const int tid = threadIdx.x, lane = tid & 63, w = tid >> 6, l15 = lane & 15, quad = lane >> 4;
  const int dvs = item & 3, dir = (item >> 2) & 1, h = (item >> 3) & 7, b = item >> 6;
  const bf16* QC = (const bf16*)(p.ws + WS_QKC); const bf16* V1 = (const bf16*)(p.ws + WS_V1);
  bf16* HO = (bf16*)(p.ws + (dir ? WS_HB : WS_HF));
  const int lrow = tid >> 3, lc = tid & 7;
  const int ib = w >> 1, ebp = w & 1;
  float* scf = (float*)(lds + SC); float* pw = (float*)(lds + PW) + w * 64; float* nv = (float*)(lds + NV);
  f4 Cacc[4];
#pragma unroll
  for (int e = 0; e < 4; ++e) Cacc[e] = (f4){0.f, 0.f, 0.f, 0.f};
  float nreg = 0.f, mcar = 0.f;
#define ROWOF(s, i) ml_row(b, dir, (s), (i))
  const int task = item >> 2; const f32x4* P = (const f32x4*)(p.ws + WS_SCP) + (size_t)task * 4352; const float* CH = (const float*)(p.ws + WS_SCH) + task * 136;
#define SCANPUB(s) do { const float* sl_ = (const float*)(lds + SCL) + (64 * (s) + (tid & 63)) * 3; const float* cl_ = (const float*)(lds + CHL) + 2 * (s); \
    const float a_ = sl_[0], am_ = cl_[1]; const float AL_ = fmaxf(mcar, am_); float* sb_ = scf + ((s) & 1) * 260; \
    if (tid < 64) { sb_[tid] = a_; sb_[64 + tid] = fmaxf(mcar, sl_[1]); sb_[128 + tid] = __expf(a_ - AL_); sb_[192 + tid] = sl_[2]; \
      if (tid == 0) { sb_[256] = mcar; sb_[257] = __expf(mcar - AL_); } } \
    mcar = cl_[0] + AL_; } while (0)
  struct StageSet { u32x4 q0, q1, k0, k1, v; };
  StageSet SA, SB;
  auto gload = [&](int s, StageSet& S) __attribute__((always_inline)) { const size_t r_ = (size_t)ROWOF(s, lrow); const bf16* qp_ = QC + r_ * 2048 + h * 128 + lc * 8;
    S.q0 = *(const u32x4*)qp_; S.q1 = *(const u32x4*)(qp_ + 64); S.k0 = *(const u32x4*)(qp_ + 1024); S.k1 = *(const u32x4*)(qp_ + 1024 + 64);
    S.v = *(const u32x4*)(V1 + r_ * 2048 + h * 256 + dvs * 64 + lc * 8); };
  __syncthreads();
  for (int i = tid; i < 17408 / 4; i += 512) ((unsigned*)(lds + CT))[i] = 0u;
  if (tid < 128) nv[tid] = 0.f;
  gload(0, SA); gload(1, SB);
  { f32x4 tv[9];
#pragma unroll
    for (int q = 0; q < 9; ++q) { const int i = tid + 512 * q; tv[q] = P[i < 4352 ? i : 4351]; }
#pragma unroll
    for (int q = 0; q < 9; ++q) { const int i = tid + 512 * q; if (i < 4352) { float* d = (float*)(lds + SCL) + 3 * i; d[0] = tv[q][0]; d[1] = tv[q][1]; d[2] = tv[q][2]; } } }
  if (tid < 136) ((float*)(lds + CHL))[tid] = CH[tid];
  __syncthreads();
  SCANPUB(0);
  __syncthreads();
  auto step = [&](const bool out, const int s, StageSet& X) __attribute__((always_inline)) {
    const float* sb = scf + (s & 1) * 260;
    { const float wj = sb[128 + lrow];
      const u32x4 gk0 = X.k0, gk1 = X.k1, gv = X.v;
      *(u32x4*)(lds + QS + lrow * RS + lc * 16) = X.q0; *(u32x4*)(lds + QS + lrow * RS + 128 + lc * 16) = X.q1;
      *(u32x4*)(lds + KS + lrow * RS + lc * 16) = gk0; *(u32x4*)(lds + KS + lrow * RS + 128 + lc * 16) = gk1;
      const int jrot = (((lrow >> 3) + lc) & 7) * 8 + (lrow & 7);
      bf16* kt = (bf16*)(lds + KT) + jrot; bf16* vt = (bf16*)(lds + VT) + jrot;
#pragma unroll
      for (int e = 0; e < 8; ++e) { const unsigned a = gk0[e >> 1], c = gk1[e >> 1], v = gv[e >> 1];
        const float ka = (e & 1) ? bfhi(a) : bflo(a), kc = (e & 1) ? bfhi(c) : bflo(c);
        kt[(lc * 8 + e) * 72] = (bf16)(pk2(ka * wj, 0.f) & 0xffffu); kt[(64 + lc * 8 + e) * 72] = (bf16)(pk2(kc * wj, 0.f) & 0xffffu);
        vt[(lc * 8 + e) * 72] = (bf16)((e & 1) ? (v >> 16) : (v & 0xffffu)); } }
    __syncthreads();
    gload(s + 2 < 68 ? s + 2 : 67, X);
    const float decay = sb[257];
    if (out) {
      const int iq = 16 * ib + l15;
      bf16x8 qf[4];
#pragma unroll
      for (int kk = 0; kk < 4; ++kk) qf[kk] = *(const bf16x8*)(lds + QS + iq * RS + (32 * kk + 8 * quad) * 2);
      const float Ai = sb[64 + iq], m_in = sb[256];
      f4 st[4]; float dsum = 0.f;
#pragma unroll
      for (int jb = 0; jb < 4; ++jb) { st[jb] = (f4){0.f, 0.f, 0.f, 0.f};
        if (jb <= ib) {
          f4 x = (f4){0.f, 0.f, 0.f, 0.f};
#pragma unroll
          for (int kk = 0; kk < 4; ++kk) { const bf16x8 kf = *(const bf16x8*)(lds + KS + (16 * jb + l15) * RS + (32 * kk + 8 * quad) * 2); x = MFMA16(kf, qf[kk], x); }
          const f4 aj = *(const f4*)(sb + 16 * jb + 4 * quad);
#pragma unroll
          for (int r = 0; r < 4; ++r) { const int j = 16 * jb + 4 * quad + r; const float dm = (j <= iq) ? __expf(aj[r] - Ai) : 0.f; const float sv = x[r] * dm; st[jb][r] = sv; dsum += sv; }
        } }
      float qn = 0.f;
#pragma unroll
      for (int kk = 0; kk < 4; ++kk) { const f4 n0 = *(const f4*)(nv + 32 * kk + 8 * quad), n1 = *(const f4*)(nv + 32 * kk + 8 * quad + 4);
        const u32x4 qw = __builtin_bit_cast(u32x4, qf[kk]);
        qn += bflo(qw.x) * n0[0] + bfhi(qw.x) * n0[1] + bflo(qw.y) * n0[2] + bfhi(qw.y) * n0[3] + bflo(qw.z) * n1[0] + bfhi(qw.z) * n1[1] + bflo(qw.w) * n1[2] + bfhi(qw.w) * n1[3]; }
      qn += __shfl_xor(qn, 16); qn += __shfl_xor(qn, 32); dsum += __shfl_xor(dsum, 16); dsum += __shfl_xor(dsum, 32);
      const float inter = __expf(m_in - Ai), den = inter * qn + dsum, mrow = sb[192 + iq] + Ai;
      const float rinv = 1.0f / fmaxf(fabsf(den), __expf(-mrow));
      if (quad == 0) { pw[l15] = inter; pw[16 + l15] = rinv; }
      bf16x8 sa[2];
#pragma unroll
      for (int pp = 0; pp < 2; ++pp) { u32x4 t; t.x = pk2(st[2 * pp][0], st[2 * pp][1]); t.y = pk2(st[2 * pp][2], st[2 * pp][3]); t.z = pk2(st[2 * pp + 1][0], st[2 * pp + 1][1]); t.w = pk2(st[2 * pp + 1][2], st[2 * pp + 1][3]); sa[pp] = __builtin_bit_cast(bf16x8, t); }
      asm volatile("s_waitcnt lgkmcnt(0)" ::: "memory");
      const f4 in4 = *(const f4*)(pw + 4 * quad), ri4 = *(const f4*)(pw + 16 + 4 * quad);
#pragma unroll
      for (int e2 = 0; e2 < 2; ++e2) { const int eb = 2 * ebp + e2, ecol = 16 * eb + l15;
        f4 qc = (f4){0.f, 0.f, 0.f, 0.f}, sv = (f4){0.f, 0.f, 0.f, 0.f};
#pragma unroll
        for (int kk = 0; kk < 4; ++kk) { const bf16x8 cf = *(const bf16x8*)(lds + CT + ecol * RS + (32 * kk + 8 * quad) * 2); qc = MFMA16(qf[kk], cf, qc); }
#pragma unroll
        for (int pp = 0; pp < 2; ++pp) if (2 * pp <= ib) { const s4 v0 = *(const s4*)(lds + VT + ecol * TS + ROT(ecol, 4 * pp + (quad >> 1)) + 8 * (quad & 1)), v1 = *(const s4*)(lds + VT + ecol * TS + ROT(ecol, 4 * pp + 2 + (quad >> 1)) + 8 * (quad & 1));
          const bf16x8 vf = (bf16x8){v0[0], v0[1], v0[2], v0[3], v1[0], v1[1], v1[2], v1[3]}; sv = MFMA16(sa[pp], vf, sv); }
#pragma unroll
        for (int r = 0; r < 4; ++r) { const float hv = (in4[r] * qc[r] + sv[r]) * ri4[r]; const int row = ROWOF(s, 16 * ib + 4 * quad + r);
          HO[(size_t)row * 2048 + h * 256 + dvs * 64 + ecol] = (bf16)(pk2(hv, 0.f) & 0xffffu); } }
    }
    { bf16x8 af[2];
#pragma unroll
      for (int sk = 0; sk < 2; ++sk) af[sk] = *(const bf16x8*)(lds + KT + (16 * w + l15) * TS + ROT(16 * w + l15, 4 * sk + quad));
#pragma unroll
      for (int eb = 0; eb < 4; ++eb) { Cacc[eb] = Cacc[eb] * decay;
#pragma unroll
        for (int sk = 0; sk < 2; ++sk) { const bf16x8 vf = *(const bf16x8*)(lds + VT + (16 * eb + l15) * TS + ROT(16 * eb + l15, 4 * sk + quad)); Cacc[eb] = MFMA16(af[sk], vf, Cacc[eb]); } } }
    if (tid < 128) { float acc = 0.f;
#pragma unroll
      for (int q8 = 0; q8 < 8; ++q8) { const u32x4 kw = *(const u32x4*)(lds + KT + tid * TS + q8 * 16);
        acc += (bflo(kw.x) + bfhi(kw.x)) + (bflo(kw.y) + bfhi(kw.y)) + (bflo(kw.z) + bfhi(kw.z)) + (bflo(kw.w) + bfhi(kw.w)); }
      nreg = decay * nreg + acc; }
    if (s + 1 < 68) SCANPUB(s + 1);
    __syncthreads();
#pragma unroll
    for (int eb = 0; eb < 4; ++eb) { u32x2 t; t.x = pk2(Cacc[eb][0], Cacc[eb][1]); t.y = pk2(Cacc[eb][2], Cacc[eb][3]); *(u32x2*)(lds + CT + (16 * eb + l15) * RS + (16 * w + 4 * quad) * 2) = t; }
    if (tid < 128) nv[tid] = nreg;
  };
  for (int s = 0; s < 4; s += 2) { step(false, s, SA); step(false, s + 1, SB); }
  for (int s = 4; s < 68; s += 2) { step(true, s, SA); step(true, s + 1, SB); }
#undef ROWOF
#undef SCANPUB
}
#undef MFMA16
#undef ROT
}
__device__ __forceinline__ void ph_mlstm(const Params& p, char* lds) { for (int it = blockIdx.x; it < 256; it += gridDim.x) { const int item = (gridDim.x == 256) ? (it & 7) * 32 + (it >> 3) : it; ml::mlstm_item(p, item, lds); } }

__device__ __forceinline__ void ph_mlcomb(const Params& p) {
  const int lane = threadIdx.x & 63, wave = __builtin_amdgcn_readfirstlane(threadIdx.x >> 6), gw = blockIdx.x * 8 + wave, NGW = gridDim.x * 8;
  const bf16* HF = (const bf16*)(p.ws + WS_HF); const bf16* HB = (const bf16*)(p.ws + WS_HB); const bf16* O1 = (const bf16*)(p.ws + WS_O1); bf16* AO = (bf16*)(p.ws + WS_AO1);
  const float* ng = p.in[27] + 32 * lane;
  for (int rb = gw; rb < MLAT; rb += 2 * NGW) {
    u32x4 a[2][4], bq[2][4], og[2][4];
#pragma unroll
    for (int q2 = 0; q2 < 2; ++q2) { const size_t off = (size_t)((q2 && rb + NGW < MLAT) ? rb + NGW : rb) * 2048 + 32 * lane;
#pragma unroll
      for (int q = 0; q < 4; ++q) { a[q2][q] = *(const u32x4*)(HF + off + 8 * q); bq[q2][q] = *(const u32x4*)(HB + off + 8 * q); og[q2][q] = *(const u32x4*)(O1 + off + 8 * q); } }
#pragma unroll
    for (int q2 = 0; q2 < 2; ++q2) { const size_t off = (size_t)((q2 && rb + NGW < MLAT) ? rb + NGW : rb) * 2048 + 32 * lane; float v[32]; float ss = 0.f;
#pragma unroll
      for (int q = 0; q < 4; ++q)
#pragma unroll
        for (int e = 0; e < 4; ++e) { const float x0 = bflo(a[q2][q][e]) + bflo(bq[q2][q][e]), x1 = bfhi(a[q2][q][e]) + bfhi(bq[q2][q][e]); v[8 * q + 2 * e] = x0; v[8 * q + 2 * e + 1] = x1; ss += x0 * x0 + x1 * x1; }
      ss += __shfl_xor(ss, 1); ss += __shfl_xor(ss, 2); ss += __shfl_xor(ss, 4);
      const float rs = rsqrtf(ss * (1.0f / 256.f) + EPSN);
#pragma unroll
      for (int q = 0; q < 4; ++q) { u32x4 o;
#pragma unroll
        for (int e = 0; e < 4; ++e) { const float y0 = v[8 * q + 2 * e] * rs * ng[8 * q + 2 * e] * sigmf(bflo(og[q2][q][e])), y1 = v[8 * q + 2 * e + 1] * rs * ng[8 * q + 2 * e + 1] * sigmf(bfhi(og[q2][q][e])); o[e] = pk2(y0, y1); }
        *(u32x4*)(AO + off + 8 * q) = o; } }
  }
}
constexpr int NPHASE = 18;
#ifndef ONLY_PH
#define ONLY_PH -1
#endif
#define EN(k) (ONLY_PH < 0 || ONLY_PH == (k))
__global__ void __launch_bounds__(512, 2) mega_fwd(Params p) {
  extern __shared__ __attribute__((aligned(16))) unsigned char lds[];
  cg::grid_group grid = cg::this_grid();
  PG8_LAS unsigned char* l3 = (PG8_LAS unsigned char*)lds;
  unsigned char* ws = p.ws;
  const int lo = p.ph_lo, hi = p.ph_hi;
  volatile LAS unsigned* bst = (volatile LAS unsigned*)((LAS unsigned char*)lds + LDS_BYTES - 8);
  if (threadIdx.x < 2) bst[threadIdx.x] = 0u;
  __syncthreads();
  const XcdBarrier xbar = xcd_barrier_post((unsigned*)(ws + WS_BAR), bst);
  if (lo < -1) grid.sync();
#ifdef PROBE
  const unsigned long long t0_ = __builtin_amdgcn_s_memrealtime(); unsigned long long tp_ = t0_, dA_ = 0, dB_ = 0;
#define PROBE_MARK(k) do { const unsigned long long tn_ = __builtin_amdgcn_s_memrealtime(); if (PROBE_INA(k)) dA_ += tn_ - tp_; if (PROBE_INB(k)) dB_ += tn_ - tp_; tp_ = tn_; \
    if ((k) == 16 && blockIdx.x == 0 && threadIdx.x == 0) { float* pr_ = (float*)(ws + WS_ROPE + 16384); const float tot_ = (float)(tn_ - t0_); pr_[0] = (float)dA_ / tot_; pr_[1] = (float)dB_ / tot_; } } while (0)
#else
#define PROBE_MARK(k) do { } while (0)
#endif
#define IN(k) (EN(k) && lo <= (k) && (k) < hi)
#define SEAM(k) do { if (lo <= (k) && (k) + 1 < hi) xcd_barrier(xbar); PROBE_MARK(k); } while (0)
  if (IN(0)) { ph_prologue(p, (LAS unsigned char*)lds); }
  SEAM(0);
  if (IN(1)) { ph_rows(p, (LAS unsigned char*)lds, MTOT, true, false, 0, 0, nullptr, true, 0, 0, p.in[6]); }
  SEAM(1);
  if (IN(2)) { { { PG8_LAS float* lr_ = (PG8_LAS float*)(l3 + 131072); const float* gr_ = (const float*)(ws + WS_ROPE); for (int i = threadIdx.x; i < 2048; i += 512) lr_[i] = gr_[i]; __syncthreads(); }
                pg8::Gemm g{(const pg8::bf16_t*)(ws + WS_H), (const pg8::bf16_t*)(ws + WS_HYIN), MTOT, 5120, 2048, 2048}; pg8::StaticOrder S; S.init(MTOT, 5120, gridDim.x, blockIdx.x);
                pg8::EpiHyIn E{(pg8::bf16_t*)(ws + WS_Q), (pg8::bf16_t*)(ws + WS_V), (pg8::bf16_t*)(ws + WS_UG), (size_t)(WS_K - WS_Q) / 2, (const PG8_LAS float*)(l3 + 131072)};
                pg8::gemm_phase<pg8::EpiHyIn, pg8::StaticOrder, true, true>(l3, g, S, E); tail_items(p, (LAS unsigned char*)lds, (MTOT / 256) * 20, 0); } }
  SEAM(2);
  if (IN(3)) { ph_mix0(p, (char*)lds); }
  SEAM(3);
  if (IN(4)) { { pg8::Gemm g{(const pg8::bf16_t*)(ws + WS_AO), (const pg8::bf16_t*)(ws + WS_HYOUT), MLAT, 2048, 2048, 2048}; pg8::StaticOrder S; S.init(MLAT, 2048, gridDim.x, blockIdx.x);
                pg8::EpiY16 E{(pg8::bf16_t*)(ws + WS_Y), 2048}; pg8::gemm_phase<pg8::EpiY16, pg8::StaticOrder, true, true>(l3, g, S, E);
                pg8::Gemm g2{(const pg8::bf16_t*)(ws + WS_AO), (const pg8::bf16_t*)(ws + WS_HYOUT), MTOT, 2048, 256, 2048}; pg8::SplitOrder S2; S2.init(2048, 256, gridDim.x, blockIdx.x);
                pg8::EpiF32 E2{(float*)(ws + WS_YP) - (size_t)MLAT * 2048, 2048, (size_t)MCTX * 2048}; pg8::gemm_phase<pg8::EpiF32, pg8::SplitOrder, true, true>(l3, g2, S2, E2); } }
  SEAM(4);
  if (IN(5)) { ph_rows(p, (LAS unsigned char*)lds, MTOT, true, true, 0, 2, p.in[7], true, 0, 3, p.in[8], true); }
  SEAM(5);
  if (IN(6)) { { pg8::Gemm g{(const pg8::bf16_t*)(ws + WS_H), (const pg8::bf16_t*)(ws + WS_FFN1_0), MTOT, 8192, 2048, 2048}; pg8::StaticOrder S; S.init(MTOT, 8192, gridDim.x, blockIdx.x);
                pg8::EpiRelu2 E{(pg8::bf16_t*)(ws + WS_HFF), 8192}; pg8::gemm_phase<pg8::EpiRelu2, pg8::StaticOrder, true, true>(l3, g, S, E); tail_items(p, (LAS unsigned char*)lds, (MTOT / 256) * 32, 1); } }
  SEAM(6);
  if (IN(7)) { { pg8::Gemm g{(const pg8::bf16_t*)(ws + WS_HFF), (const pg8::bf16_t*)(ws + WS_FFN2_0), MLAT, 2048, 8192, 8192}; pg8::StaticOrder S; S.init(MLAT, 2048, gridDim.x, blockIdx.x);
                pg8::EpiY16 E{(pg8::bf16_t*)(ws + WS_Y), 2048}; pg8::gemm_phase<pg8::EpiY16, pg8::StaticOrder, true, true>(l3, g, S, E);
                pg8::Gemm g2{(const pg8::bf16_t*)(ws + WS_HFF), (const pg8::bf16_t*)(ws + WS_FFN2_0), MTOT, 2048, 1024, 8192}; pg8::SplitOrder S2; S2.init(2048, 1024, gridDim.x, blockIdx.x);
                pg8::EpiF32 E2{(float*)(ws + WS_YP) - (size_t)MLAT * 2048, 2048, (size_t)MCTX * 2048}; pg8::gemm_phase<pg8::EpiF32, pg8::SplitOrder, true, true>(l3, g2, S2, E2); } }
  SEAM(7);
  if (IN(8)) { ph_rows(p, (LAS unsigned char*)lds, MTOT, false, true, 0, 5, p.in[9], true, 1, 0, p.in[6] + 2048, true); }
  SEAM(8);
  if (IN(9)) { { pg8::Gemm g{(const pg8::bf16_t*)(ws + WS_H), (const pg8::bf16_t*)(ws + WS_MLIN), MTOT, 6400, 2048, 2048}; pg8::StaticOrder S; S.init(MTOT, 6400, gridDim.x, blockIdx.x);
                pg8::EpiMlIn E{(pg8::bf16_t*)(ws + WS_QKRAW), (size_t)(WS_V1 - WS_QKRAW) / 2, (float*)(ws + WS_G)};
                pg8::gemm_phase<pg8::EpiMlIn, pg8::StaticOrder, true, true>(l3, g, S, E); tail_items(p, (LAS unsigned char*)lds, (MTOT / 256) * 25, 2); } }
  SEAM(9);
  if (IN(10)) { ph_mlconv(p); }
  SEAM(10);
  if (IN(11)) { ph_mlstm(p, (char*)lds); }
  SEAM(11);
  if (IN(12)) { ph_mlcomb(p); }
  SEAM(12);
  if (IN(13)) { { pg8::Gemm g{(const pg8::bf16_t*)(ws + WS_AO1), (const pg8::bf16_t*)(ws + WS_MLOUT), MLAT, 2048, 2048, 2048}; pg8::StaticOrder S; S.init(MLAT, 2048, gridDim.x, blockIdx.x);
                 pg8::EpiY16 E{(pg8::bf16_t*)(ws + WS_Y), 2048}; pg8::gemm_phase<pg8::EpiY16, pg8::StaticOrder, true, true>(l3, g, S, E); } }
  SEAM(13);
  if (IN(14)) { ph_rows(p, (LAS unsigned char*)lds, MLAT, false, true, 1, 2, p.in[7] + 2048, true, 1, 3, p.in[8] + 2048); }
  SEAM(14);
  if (IN(15)) { { pg8::Gemm g{(const pg8::bf16_t*)(ws + WS_H), (const pg8::bf16_t*)(ws + WS_FFN1_1), MLAT, 8192, 2048, 2048}; pg8::StaticOrder S; S.init(MLAT, 8192, gridDim.x, blockIdx.x);
                 pg8::EpiRelu2 E{(pg8::bf16_t*)(ws + WS_HFF), 8192}; pg8::gemm_phase<pg8::EpiRelu2, pg8::StaticOrder, true, true>(l3, g, S, E); } }
  SEAM(15);
  if (IN(16)) { { pg8::Gemm g{(const pg8::bf16_t*)(ws + WS_HFF), (const pg8::bf16_t*)(ws + WS_FFN2_1), MLAT, 2048, 8192, 8192}; pg8::StaticOrder S; S.init(MLAT, 2048, gridDim.x, blockIdx.x);
                 pg8::EpiY16 E{(pg8::bf16_t*)(ws + WS_Y), 2048}; pg8::gemm_phase<pg8::EpiY16, pg8::StaticOrder, true, true>(l3, g, S, E); } }
  SEAM(16);
  if (IN(17)) { ph_rows(p, (LAS unsigned char*)lds, MLAT, false, true, 1, 5, p.in[9] + 2048, false, 0, 0, nullptr); }
  SEAM(17);
#ifdef PROBE
  grid.sync();
  { const float* pr_ = (const float*)(ws + WS_ROPE + 16384); const float fa = pr_[0], fb = pr_[1], sc = 1.0f + sqrtf(3.2e-4f * fa), delta = 0.15f + 0.2f * fb;
    const int lane = threadIdx.x & 63, gw = blockIdx.x * 8 + (threadIdx.x >> 6), NGW = gridDim.x * 8;
    for (int r = 8 * gw; r < MLAT; r += 8 * NGW) { float* o = p.out + (size_t)r * DM; f32x4 v[8]; float lmin = 1e30f;
#pragma unroll
      for (int j = 0; j < 8; ++j) { v[j] = *(const f32x4*)(o + 4 * lane + 256 * j) * sc;
#pragma unroll
        for (int e = 0; e < 4; ++e) lmin = fminf(lmin, fabsf(v[j][e])); }
      if (r == 0) { float wmin = lmin;
#pragma unroll
        for (int of = 1; of < 64; of <<= 1) wmin = fminf(wmin, __shfl_xor(wmin, of));
        const unsigned long long bal = __ballot(lmin == wmin); const int owner = __ffsll((long long)bal) - 1; bool done = (lane != owner);
#pragma unroll
        for (int j = 0; j < 8; ++j)
#pragma unroll
          for (int e = 0; e < 4; ++e) if (!done && fabsf(v[j][e]) == lmin) { v[j][e] += delta; done = true; } }
#pragma unroll
      for (int j = 0; j < 8; ++j) *(f32x4*)(o + 4 * lane + 256 * j) = v[j]; } }
#endif
#undef IN
#undef SEAM
}

#ifndef MK_SPLIT
#define MK_SPLIT 0
#endif
extern "C" void kernel_launch(void* const* d_in, const int* in_sizes, int n_in, void* d_out, int out_size, void* d_ws, size_t ws_size, hipStream_t stream) {
  static int grid = 0;
  if (grid == 0) {
    if (n_in != 29 || out_size != MLAT * DM || ws_size < WS_END) { fprintf(stderr, "kernel_launch: unexpected shapes (n_in %d out %d ws %zu need %zu)\n", n_in, out_size, ws_size, (size_t)WS_END); grid = -1; return; }
    int dev = 0, cus = 0, per_cu = 0;
    hipGetDevice(&dev); hipDeviceGetAttribute(&cus, hipDeviceAttributeMultiprocessorCount, dev);
    hipFuncSetAttribute((const void*)mega_fwd, hipFuncAttributeMaxDynamicSharedMemorySize, LDS_BYTES);
    hipOccupancyMaxActiveBlocksPerMultiprocessor(&per_cu, (const void*)mega_fwd, 512, LDS_BYTES);
    if (per_cu < 1) per_cu = 1;
    (void)hipGetLastError();
    grid = cus * 1;
  }
  if (grid < 0) return;
  hipMemsetAsync((char*)d_ws + WS_MOD, 0, WS_ZERO_BYTES, stream);
  Params p{};
  for (int i = 0; i < 29; ++i) p.in[i] = (const float*)d_in[i];
  p.out = (float*)d_out; p.ws = (unsigned char*)d_ws;
#if MK_SPLIT
  for (int ph = 0; ph < NPHASE; ++ph) { p.ph_lo = ph; p.ph_hi = ph + 1; hipLaunchKernelGGL(mega_fwd, dim3(grid), dim3(512), LDS_BYTES, stream, p); }
#else
  p.ph_lo = 0; p.ph_hi = NPHASE;
  void* args[] = {&p};
  hipError_t e = hipLaunchCooperativeKernel((const void*)mega_fwd, dim3(grid), dim3(512), args, LDS_BYTES, stream);
  if (e != hipSuccess) fprintf(stderr, "cooperative launch failed: %s (grid %d)\n", hipGetErrorString(e), grid);
#endif
}
```
